# Optimizing an MI355X kernel written in HIP

```python
import math
import jax, jax.numpy as jnp
from jax import lax
import numpy as np


D_MODEL = 2048
BATCH = 4
SEQ = 4096
DEPTH = 2

CHUNK = 64
EPS = 1e-6
D_FF = ((8 * D_MODEL) // 3 + 255) // 256 * 256

POOL_WINDOWS = (2, 4, 8, 16)
POOL_WIDTH = D_MODEL // 4
POOL_GROUP = POOL_WIDTH // len(POOL_WINDOWS)
SB_HEAD_DIM = 128
SB_HEADS = (D_MODEL - POOL_WIDTH) // SB_HEAD_DIM
SB_WIDTH = SB_HEADS * SB_HEAD_DIM
SB_BLOCK = 128
EVEN_IN = POOL_WIDTH + 3 * SB_WIDTH
EVEN_MIX = POOL_WIDTH + SB_WIDTH

SSM_WIDTH = D_MODEL // 2
SSM_GROUP = 16
SSM_GROUPS = SSM_WIDTH // SSM_GROUP
SSM_STATE = 64
SGU_WIDTH = D_MODEL // 2
SGU_HEADS = 8
SGU_HEAD_DIM = SGU_WIDTH // SGU_HEADS
SGU_LEN = 128
ODD_IN = SSM_WIDTH + 2 * SGU_WIDTH
ODD_MIX = SSM_WIDTH + SGU_WIDTH

N_EVEN = (DEPTH + 1) // 2
N_ODD = DEPTH // 2

kernel_name = 'hybrid_pool_stickbreak_s5_sgu_macaron'


def rmsnorm(x, g):
    xf = x.astype(jnp.float32)
    y = xf * lax.rsqrt(jnp.mean(xf * xf, axis=-1, keepdims=True) + EPS)
    return (y * g.astype(jnp.float32)).astype(x.dtype)


def swiglu(x, w_gate, w_up, w_down):
    return (jax.nn.silu(x @ w_gate) * (x @ w_up)) @ w_down


def pool_mixer(u, w_group, scale):
    Bsz, L, _ = u.shape
    uf = u.astype(jnp.float32)
    cs = jnp.pad(jnp.cumsum(uf, axis=1), ((0, 0), (1, 0), (0, 0)))
    count = jnp.arange(1, L + 1, dtype=jnp.float32)[None, :, None]
    means = []
    for gi, w in enumerate(POOL_WINDOWS):
        c = cs[..., gi * POOL_GROUP:(gi + 1) * POOL_GROUP]
        lo = jnp.pad(c[:, :L + 1 - w], ((0, 0), (w - 1, 0), (0, 0)))
        means.append((c[:, 1:] - lo) / jnp.minimum(count, float(w)))
    pooled = jnp.concatenate(means, axis=-1) - uf
    pooled = pooled.reshape(Bsz, L, len(POOL_WINDOWS), POOL_GROUP)
    y = jnp.einsum('blgc,gcd->blgd', pooled, w_group).reshape(Bsz, L, POOL_WIDTH)
    return (y * scale).astype(u.dtype)


def stick_breaking(q, k, v):
    L = q.shape[2]
    scale = SB_HEAD_DIM ** -0.5
    outs = []
    for i in range(L // SB_BLOCK):
        q0 = i * SB_BLOCK
        kend = q0 + SB_BLOCK
        qb = q[:, :, q0:kend]
        kb = k[:, :, :kend]
        vb = v[:, :, :kend]
        z = jnp.einsum('bhqd,bhkd->bhqk', qb, kb).astype(jnp.float32) * scale
        t_pos = q0 + jnp.arange(SB_BLOCK)[:, None]
        s_pos = jnp.arange(kend)[None, :]
        mask = s_pos < t_pos
        log_keep = jnp.where(mask, jax.nn.log_sigmoid(-z), 0.0)
        later = lax.cumsum(log_keep, axis=3, reverse=True) - log_keep
        w = jnp.where(mask, jnp.exp(jax.nn.log_sigmoid(z) + later), 0.0)
        outs.append(jnp.einsum('bhqk,bhkd->bhqd', w.astype(vb.dtype), vb))
    return jnp.concatenate(outs, axis=2)


def even_mixer(h, w_in, pool_w, pool_scale, w_out):
    Bsz, L, _ = h.shape
    p = h @ w_in
    u_pool = p[..., :POOL_WIDTH]
    qkv = p[..., POOL_WIDTH:].reshape(Bsz, L, 3, SB_HEADS, SB_HEAD_DIM)
    q = jnp.transpose(qkv[:, :, 0], (0, 2, 1, 3))
    k = jnp.transpose(qkv[:, :, 1], (0, 2, 1, 3))
    v = jnp.transpose(qkv[:, :, 2], (0, 2, 1, 3))
    y_pool = pool_mixer(u_pool, pool_w, pool_scale)
    y_sb = jnp.transpose(stick_breaking(q, k, v), (0, 2, 1, 3)).reshape(Bsz, L, SB_WIDTH)
    return jnp.concatenate([y_pool, y_sb.astype(y_pool.dtype)], axis=-1) @ w_out


def s5_ssm(u, a_re, a_im, log_dt, b_re, b_im, c_re, c_im, d_skip, glu_w, glu_b):
    Bsz, L, _ = u.shape
    f32 = jnp.float32
    uf = u.astype(f32).reshape(Bsz, L, SSM_GROUPS, SSM_GROUP)
    a_re = a_re.astype(f32)
    a_im = a_im.astype(f32)
    b_re = b_re.astype(f32)
    b_im = b_im.astype(f32)
    dt = jnp.exp(log_dt.astype(f32))[:, None]
    mag = jnp.exp(a_re * dt)
    lam_re = mag * jnp.cos(a_im * dt)
    lam_im = mag * jnp.sin(a_im * dt)
    den = a_re * a_re + a_im * a_im
    nr = lam_re - 1.0
    f_re = (nr * a_re + lam_im * a_im) / den
    f_im = (lam_im * a_re - nr * a_im) / den
    bb_re = f_re[..., None] * b_re - f_im[..., None] * b_im
    bb_im = f_re[..., None] * b_im + f_im[..., None] * b_re
    bu_re = jnp.einsum('gnc,blgc->lbgn', bb_re, uf)
    bu_im = jnp.einsum('gnc,blgc->lbgn', bb_im, uf)
    lr = jnp.broadcast_to(lam_re[None, None], (L, 1, SSM_GROUPS, SSM_STATE))
    li = jnp.broadcast_to(lam_im[None, None], (L, 1, SSM_GROUPS, SSM_STATE))

    def combine(left, right):
        ar1, ai1, br1, bi1 = left
        ar2, ai2, br2, bi2 = right
        return (ar2 * ar1 - ai2 * ai1, ar2 * ai1 + ai2 * ar1,
                ar2 * br1 - ai2 * bi1 + br2, ar2 * bi1 + ai2 * br1 + bi2)

    _, _, s_re, s_im = lax.associative_scan(combine, (lr, li, bu_re, bu_im), axis=0)
    y = (jnp.einsum('gcn,lbgn->blgc', c_re.astype(f32), s_re)
         - jnp.einsum('gcn,lbgn->blgc', c_im.astype(f32), s_im))
    y = y.reshape(Bsz, L, SSM_WIDTH) + d_skip.astype(f32) * uf.reshape(Bsz, L, SSM_WIDTH)
    y = jax.nn.gelu(y)
    y = y * jax.nn.sigmoid(y @ glu_w.astype(f32) + glu_b.astype(f32))
    return y.astype(u.dtype)


def spatial_gating(z, norm_g, w_s, b_s):
    Bsz, L, _ = z.shape
    z = jax.nn.gelu(z)
    u = z[..., :SGU_WIDTH]
    v = rmsnorm(z[..., SGU_WIDTH:], norm_g)
    v = v.reshape(Bsz, L // SGU_LEN, SGU_LEN, SGU_HEADS, SGU_HEAD_DIM)
    w_causal = jnp.tril(w_s)
    mixed = jnp.einsum('hts,bnshd->bnthd', w_causal, v) + jnp.transpose(b_s)[None, None, :, :, None]
    u = u.reshape(Bsz, L // SGU_LEN, SGU_LEN, SGU_HEADS, SGU_HEAD_DIM)
    return (u * mixed).reshape(Bsz, L, SGU_WIDTH)


def odd_mixer(h, w_in, a_re, a_im, log_dt, b_re, b_im, c_re, c_im, d_skip, glu_w, glu_b,
              sgu_norm_g, sgu_w, sgu_b, w_out):
    p = h @ w_in
    y_ssm = s5_ssm(p[..., :SSM_WIDTH], a_re, a_im, log_dt, b_re, b_im, c_re, c_im,
                   d_skip, glu_w, glu_b)
    y_sgu = spatial_gating(p[..., SSM_WIDTH:], sgu_norm_g, sgu_w, sgu_b)
    return jnp.concatenate([y_ssm, y_sgu.astype(y_ssm.dtype)], axis=-1) @ w_out


def setup_inputs(seed: int = 0) -> dict:
    key = jax.random.key(seed)
    ks = jax.random.split(key, 24)
    nrm = jax.random.normal
    f32 = jnp.float32
    G, N, C = SSM_GROUPS, SSM_STATE, SSM_GROUP
    x = nrm(ks[0], (BATCH, SEQ, D_MODEL), f32)
    norm_g = 1.0 + 0.02 * nrm(ks[1], (DEPTH, 6, D_MODEL), f32)
    ffn_w_gate = nrm(ks[2], (DEPTH, 2, D_MODEL, D_FF), f32) * D_MODEL ** -0.5
    ffn_w_up = nrm(ks[3], (DEPTH, 2, D_MODEL, D_FF), f32) * D_MODEL ** -0.5
    ffn_w_down = nrm(ks[4], (DEPTH, 2, D_FF, D_MODEL), f32) * D_FF ** -0.5
    ev_w_in = nrm(ks[5], (N_EVEN, D_MODEL, EVEN_IN), f32) * D_MODEL ** -0.5
    ev_pool_w = nrm(ks[6], (N_EVEN, len(POOL_WINDOWS), POOL_GROUP, POOL_GROUP), f32) * POOL_GROUP ** -0.5
    ev_pool_scale = 1.0 + 0.02 * nrm(ks[7], (N_EVEN, POOL_WIDTH), f32)
    ev_w_out = nrm(ks[8], (N_EVEN, EVEN_MIX, D_MODEL), f32) * EVEN_MIX ** -0.5
    od_w_in = nrm(ks[9], (N_ODD, D_MODEL, ODD_IN), f32) * D_MODEL ** -0.5
    od_ssm_a_re = -0.5 + 0.01 * nrm(ks[10], (N_ODD, G, N), f32)
    od_ssm_a_im = (math.pi * jnp.arange(N, dtype=f32))[None, None, :] + 0.01 * nrm(ks[11], (N_ODD, G, N), f32)
    od_ssm_log_dt = jax.random.uniform(ks[12], (N_ODD, G), f32, math.log(1e-3), math.log(1e-1))
    od_ssm_b_re = nrm(ks[13], (N_ODD, G, N, C), f32) * (2.0 * C) ** -0.5
    od_ssm_b_im = nrm(ks[14], (N_ODD, G, N, C), f32) * (2.0 * C) ** -0.5
    od_ssm_c_re = nrm(ks[15], (N_ODD, G, C, N), f32) * (2.0 * N) ** -0.5
    od_ssm_c_im = nrm(ks[16], (N_ODD, G, C, N), f32) * (2.0 * N) ** -0.5
    od_ssm_d = nrm(ks[17], (N_ODD, SSM_WIDTH), f32)
    od_glu_w = nrm(ks[18], (N_ODD, SSM_WIDTH, SSM_WIDTH), f32) * SSM_WIDTH ** -0.5
    od_glu_b = 0.01 * nrm(ks[19], (N_ODD, SSM_WIDTH), f32)
    od_sgu_norm_g = 1.0 + 0.02 * nrm(ks[20], (N_ODD, SGU_WIDTH), f32)
    od_sgu_w = nrm(ks[21], (N_ODD, SGU_HEADS, SGU_LEN, SGU_LEN), f32) * SGU_LEN ** -0.5
    od_sgu_b = 1.0 + 0.02 * nrm(ks[22], (N_ODD, SGU_HEADS, SGU_LEN), f32)
    od_w_out = nrm(ks[23], (N_ODD, ODD_MIX, D_MODEL), f32) * ODD_MIX ** -0.5
    return {'x': x, 'norm_g': norm_g, 'ffn_w_gate': ffn_w_gate, 'ffn_w_up': ffn_w_up,
            'ffn_w_down': ffn_w_down, 'ev_w_in': ev_w_in, 'ev_pool_w': ev_pool_w,
            'ev_pool_scale': ev_pool_scale, 'ev_w_out': ev_w_out, 'od_w_in': od_w_in,
            'od_ssm_a_re': od_ssm_a_re, 'od_ssm_a_im': od_ssm_a_im, 'od_ssm_log_dt': od_ssm_log_dt,
            'od_ssm_b_re': od_ssm_b_re, 'od_ssm_b_im': od_ssm_b_im, 'od_ssm_c_re': od_ssm_c_re,
            'od_ssm_c_im': od_ssm_c_im, 'od_ssm_d': od_ssm_d, 'od_glu_w': od_glu_w,
            'od_glu_b': od_glu_b, 'od_sgu_norm_g': od_sgu_norm_g, 'od_sgu_w': od_sgu_w,
            'od_sgu_b': od_sgu_b, 'od_w_out': od_w_out}


def reference(x, norm_g, ffn_w_gate, ffn_w_up, ffn_w_down, ev_w_in, ev_pool_w, ev_pool_scale,
              ev_w_out, od_w_in, od_ssm_a_re, od_ssm_a_im, od_ssm_log_dt, od_ssm_b_re, od_ssm_b_im,
              od_ssm_c_re, od_ssm_c_im, od_ssm_d, od_glu_w, od_glu_b, od_sgu_norm_g, od_sgu_w,
              od_sgu_b, od_w_out):
    for i in range(DEPTH):
        g = norm_g[i]
        f = swiglu(rmsnorm(x, g[0]), ffn_w_gate[i, 0], ffn_w_up[i, 0], ffn_w_down[i, 0])
        x = x + 0.5 * rmsnorm(f, g[1])
        h = rmsnorm(x, g[2])
        if i % 2 == 0:
            j = i // 2
            m = even_mixer(h, ev_w_in[j], ev_pool_w[j], ev_pool_scale[j], ev_w_out[j])
        else:
            j = i // 2
            m = odd_mixer(h, od_w_in[j], od_ssm_a_re[j], od_ssm_a_im[j], od_ssm_log_dt[j],
                          od_ssm_b_re[j], od_ssm_b_im[j], od_ssm_c_re[j], od_ssm_c_im[j],
                          od_ssm_d[j], od_glu_w[j], od_glu_b[j], od_sgu_norm_g[j],
                          od_sgu_w[j], od_sgu_b[j], od_w_out[j])
        x = x + rmsnorm(m.astype(x.dtype), g[3])
        f = swiglu(rmsnorm(x, g[4]), ffn_w_gate[i, 1], ffn_w_up[i, 1], ffn_w_down[i, 1])
        x = x + 0.5 * rmsnorm(f, g[5])
    return x
```

```cpp
#include <hip/hip_runtime.h>
#include <hip/hip_cooperative_groups.h>
#include <cstdio>
#include <cstdint>
namespace cg = cooperative_groups;
namespace pg8 {
#define PG8_LAS __attribute__((address_space(3)))
typedef unsigned short bf16_t;
typedef short bf16x8 __attribute__((ext_vector_type(8)));
typedef float f32x4 __attribute__((ext_vector_type(4)));
typedef unsigned u32x4 __attribute__((ext_vector_type(4)));
constexpr int BM = 256, BK = 64, HALF = 128, HTB = HALF * BK * 2  , STAGE_BYTES = 8 * HTB, NXCD = 8, WGM = 8;

__host__ __device__ __forceinline__ int lds_byte(int r, int c) { const int st = (r >> 4) * 2 + (c >> 5), rr = r & 15, cc = c & 31, ob = rr * 64 + cc * 2; return st * 1024 + (ob ^ (((ob >> 9) & 1) << 5)); }
__host__ __device__ __forceinline__ void stage_rc(int b, int& R, int& C) { const int st = b / 1024, sb = b % 1024, swz = sb ^ (((sb >> 9) & 1) << 5); R = (st >> 1) * 16 + swz / 64; C = (st & 1) * 32 + (swz % 64) / 2; }
__host__ __device__ __forceinline__ int perm32(int rho) { const int n = rho >> 4, i = rho & 15; return 8 * (i >> 2) + 4 * n + (i & 3); }

struct Unit { int pm, pn; };
struct Gemm { const bf16_t* A; const bf16_t* Bt; int M, N, K; };

struct StaticOrder {
    int nM, nN, nwg, G, c;
    __host__ __device__ void init(int M, int N, int G_, int c_) { nM = M / BM; nN = N / BM; nwg = nM * nN; G = G_; c = c_; }
    __host__ __device__ bool next(int i, Unit& u) const {
        const long L = (long)i * G + c; if (L >= nwg) return false;
        int wgid = (int)L; { const int q = nwg / NXCD, r = nwg % NXCD, xcd = wgid % NXCD, off = wgid / NXCD; wgid = (xcd < r ? xcd * (q + 1) : r * (q + 1) + (xcd - r) * q) + off; }
        const int nig = WGM * nN, gid = wgid / nig, fm = gid * WGM, gsz = (nM - fm) < WGM ? (nM - fm) : WGM;
        u.pm = fm + ((wgid % nig) % gsz); u.pn = (wgid % nig) / gsz; return true;
    }
    __device__ __forceinline__ void a_ready(const Unit&) const {}
    __device__ __forceinline__ void done(const Unit&) const {}
};

__device__ __forceinline__ unsigned cvt_pk_bf16(float lo, float hi) { unsigned r; asm volatile("v_cvt_pk_bf16_f32 %0, %1, %2" : "=v"(r) : "v"(lo), "v"(hi)); return r; }
typedef float f32x2 __attribute__((ext_vector_type(2)));
__device__ __forceinline__ f32x2 gelu_pk(f32x2 v) {
    const f32x2 av = __builtin_elementwise_abs(v), d = av * 0.2316418882f + 1.0f;
    f32x2 t; t.x = __builtin_amdgcn_rcpf(d.x); t.y = __builtin_amdgcn_rcpf(d.y);
    f32x2 q = t * 0.5307027145f + (-0.7265760135f); q = q * t + 0.7107068705f; q = q * t + (-0.142248368f); q = q * t + 0.127414796f; q = q * t;
    const f32x2 s = (v * v) * (-0.72134752044f);
    f32x2 e; e.x = __builtin_amdgcn_exp2f(s.x); e.y = __builtin_amdgcn_exp2f(s.y);
    const f32x2 m = v * (q * e), r = v - m;
    f32x2 o; o.x = v.x < 0.f ? m.x : r.x; o.y = v.y < 0.f ? m.y : r.y; return o;
}

template <int ACT  > struct EpiBf16 {
    static constexpr bool PERM = true, AFTER_DRAIN = false; static_assert(ACT == 0 || ACT == 1, "EpiBf16: ACT is 0 (none) or 1 (gelu_pk)");
    bf16_t* O; int ldc; const float* bias; int split_cols; size_t split_stride; float scale0;
    __device__ __forceinline__ void operator()(const f32x4 (&acc)[2][2][4][2], const Unit& u, int wr, int wc, int fr, int fq) const {
        const int row0 = u.pm * BM + wr * 64 + fr; int colt = u.pn * BM; bf16_t* base = O;
        float sc = 1.f; if (split_cols) { const int t = colt / split_cols; base += (size_t)t * split_stride; colt -= t * split_cols; if (t == 0) sc = scale0; }
        const int col0 = colt + wc * 32 + 8 * fq, bcol0 = u.pn * BM + wc * 32 + 8 * fq;
        f32x4 bv[2][2];
#pragma unroll
        for (int bj = 0; bj < 2; ++bj)
#pragma unroll
            for (int n = 0; n < 2; ++n) bv[bj][n] = bias ? *(const f32x4*)(bias + bcol0 + bj * HALF + 4 * n) : (f32x4){0.f, 0.f, 0.f, 0.f};
#pragma unroll
        for (int ai = 0; ai < 2; ++ai)
#pragma unroll
            for (int m = 0; m < 4; ++m) { bf16_t* rowp = base + (size_t)(row0 + ai * HALF + m * 16) * ldc + col0;
#pragma unroll
                for (int bj = 0; bj < 2; ++bj) { f32x4 v0 = acc[ai][bj][m][0] + bv[bj][0], v1 = acc[ai][bj][m][1] + bv[bj][1];
                    if (ACT == 1) { f32x2 a = gelu_pk((f32x2){v0[0], v0[1]}), b = gelu_pk((f32x2){v0[2], v0[3]}), c = gelu_pk((f32x2){v1[0], v1[1]}), d = gelu_pk((f32x2){v1[2], v1[3]});
                        v0 = (f32x4){a.x, a.y, b.x, b.y}; v1 = (f32x4){c.x, c.y, d.x, d.y}; }
                    v0 = v0 * sc; v1 = v1 * sc; u32x4 w; w.x = cvt_pk_bf16(v0[0], v0[1]); w.y = cvt_pk_bf16(v0[2], v0[3]); w.z = cvt_pk_bf16(v1[0], v1[1]); w.w = cvt_pk_bf16(v1[2], v1[3]);
                    *(u32x4*)(rowp + bj * HALF) = w; } }
    }
};

__device__ __forceinline__ float sigm_f(float x) { return __builtin_amdgcn_rcpf(1.0f + __expf(-x)); }
__device__ __forceinline__ float silu_f(float x) { return x * sigm_f(x); }
__device__ __forceinline__ float gelu_f(float x) { return x * sigm_f(x * (1.5957691216f + 0.0713548163f * x * x)); }
__device__ __forceinline__ unsigned short f2bf_rne(float f) { unsigned u = __builtin_bit_cast(unsigned, f); return (unsigned short)((u + 0x7fffu + ((u >> 16) & 1u)) >> 16); }

__device__ __forceinline__ f32x2 silu_mul_pk(f32x2 g, f32x2 u) {
    const f32x2 e = g * (-1.4426950408889634f);
    f32x2 d; d.x = __builtin_amdgcn_exp2f(e.x); d.y = __builtin_amdgcn_exp2f(e.y);
    d = d + 1.0f;
    f32x2 r; r.x = __builtin_amdgcn_rcpf(d.x); r.y = __builtin_amdgcn_rcpf(d.y);
    return (g * u) * r;
}
struct EpiSwiglu {
    static constexpr bool PERM = true, AFTER_DRAIN = false;
    bf16_t* O; int ldc;
    __device__ __forceinline__ void operator()(const f32x4 (&acc)[2][2][4][2], const Unit& u, int wr, int wc, int fr, int fq) const {
        const int row0 = u.pm * BM + wr * 64 + fr, col0 = u.pn * HALF + wc * 32 + 8 * fq;
#pragma unroll
        for (int ai = 0; ai < 2; ++ai)
#pragma unroll
            for (int m = 0; m < 4; ++m) { bf16_t* rowp = O + (size_t)(row0 + ai * HALF + m * 16) * ldc + col0;
                const f32x4 g0 = acc[ai][0][m][0], g1 = acc[ai][0][m][1], u0 = acc[ai][1][m][0], u1 = acc[ai][1][m][1];
                const f32x2 a = silu_mul_pk((f32x2){g0[0], g0[1]}, (f32x2){u0[0], u0[1]}), b = silu_mul_pk((f32x2){g0[2], g0[3]}, (f32x2){u0[2], u0[3]});
                const f32x2 c = silu_mul_pk((f32x2){g1[0], g1[1]}, (f32x2){u1[0], u1[1]}), d = silu_mul_pk((f32x2){g1[2], g1[3]}, (f32x2){u1[2], u1[3]});
                u32x4 w; w.x = cvt_pk_bf16(a.x, a.y); w.y = cvt_pk_bf16(b.x, b.y); w.z = cvt_pk_bf16(c.x, c.y); w.w = cvt_pk_bf16(d.x, d.y);
                *(u32x4*)rowp = w; }
    }
};

struct EpiIn {
    static constexpr bool PERM = true, AFTER_DRAIN = false;
    bf16_t* O; int ldc; bf16_t* VT; int ldt; int split, gelu_from;
    __device__ __forceinline__ void operator()(const f32x4 (&acc)[2][2][4][2], const Unit& u, int wr, int wc, int fr, int fq) const {
        const int row0 = u.pm * BM + wr * 64 + fr, colt = u.pn * BM; const bool act = colt >= gelu_from;
        if (colt < split) {
            const int col0 = colt + wc * 32 + 8 * fq;
#pragma unroll
            for (int ai = 0; ai < 2; ++ai)
#pragma unroll
                for (int m = 0; m < 4; ++m) { bf16_t* rowp = O + (size_t)(row0 + ai * HALF + m * 16) * ldc + col0;
#pragma unroll
                    for (int bj = 0; bj < 2; ++bj) { f32x4 v0 = acc[ai][bj][m][0], v1 = acc[ai][bj][m][1];
                        if (act) {
#pragma unroll
                            for (int i = 0; i < 4; ++i) { v0[i] = gelu_f(v0[i]); v1[i] = gelu_f(v1[i]); } }
                        u32x4 w; w.x = cvt_pk_bf16(v0[0], v0[1]); w.y = cvt_pk_bf16(v0[2], v0[3]); w.z = cvt_pk_bf16(v1[0], v1[1]); w.w = cvt_pk_bf16(v1[2], v1[3]);
                        *(u32x4*)(rowp + bj * HALF) = w; } }
        } else {
            const int c0 = colt - split + wc * 32 + 8 * fq;
#pragma unroll
            for (int ai = 0; ai < 2; ++ai)
#pragma unroll
                for (int m = 0; m < 4; ++m) { const int row = row0 + ai * HALF + m * 16;
#pragma unroll
                    for (int bj = 0; bj < 2; ++bj)
#pragma unroll
                        for (int n = 0; n < 2; ++n) { f32x4 v = acc[ai][bj][m][n];
#pragma unroll
                            for (int i = 0; i < 4; ++i) { const float x = act ? gelu_f(v[i]) : v[i];
                                VT[(size_t)(c0 + bj * HALF + 4 * n + i) * ldt + row] = f2bf_rne(x); } } }
        }
    }
};

struct EpiGlu {
    static constexpr bool PERM = true, AFTER_DRAIN = false;
    const bf16_t* Y; int ldy; const float* bias; bf16_t* O; int ldc;
    __device__ __forceinline__ void operator()(const f32x4 (&acc)[2][2][4][2], const Unit& u, int wr, int wc, int fr, int fq) const {
        const int row0 = u.pm * BM + wr * 64 + fr, col0 = u.pn * BM + wc * 32 + 8 * fq;
#pragma unroll
        for (int ai = 0; ai < 2; ++ai)
#pragma unroll
            for (int m = 0; m < 4; ++m) { const int row = row0 + ai * HALF + m * 16;
#pragma unroll
                for (int bj = 0; bj < 2; ++bj) { const int col = col0 + bj * HALF;
                    const u32x4 yv = *(const u32x4*)(Y + (size_t)row * ldy + col);
                    const f32x4 b0 = *(const f32x4*)(bias + col), b1 = *(const f32x4*)(bias + col + 4);
                    const f32x4 v0 = acc[ai][bj][m][0] + b0, v1 = acc[ai][bj][m][1] + b1;
                    float y[8];
#pragma unroll
                    for (int i = 0; i < 4; ++i) { y[2 * i] = __builtin_bit_cast(float, yv[i] << 16); y[2 * i + 1] = __builtin_bit_cast(float, yv[i] & 0xffff0000u); }
                    u32x4 w; w.x = cvt_pk_bf16(y[0] * sigm_f(v0[0]), y[1] * sigm_f(v0[1])); w.y = cvt_pk_bf16(y[2] * sigm_f(v0[2]), y[3] * sigm_f(v0[3]));
                    w.z = cvt_pk_bf16(y[4] * sigm_f(v1[0]), y[5] * sigm_f(v1[1])); w.w = cvt_pk_bf16(y[6] * sigm_f(v1[2]), y[7] * sigm_f(v1[3]));
                    *(u32x4*)(O + (size_t)row * ldc + col) = w; } }
    }
};


template <class Epi, class Sched, bool ALIGN_EPI = false, bool SP2 = false>
__device__ __forceinline__ void gemm_phase(PG8_LAS unsigned char* lds, const Gemm g, const Sched& S, const Epi& E) {
    int tid_ = threadIdx.x; asm volatile("" : "+v"(tid_));
    const int tid = tid_, wid = __builtin_amdgcn_readfirstlane(tid >> 6), lane = tid & 63, wr = wid >> 2, wc = wid & 3, fr = lane & 15, fq = lane >> 4;
    const int K = g.K, nt = K / BK;
    unsigned voffA[2], voffB[2];
#pragma unroll
    for (int i = 0; i < 2; ++i) { int R, C; stage_rc(tid * 16 + i * 8192, R, C); const int Rb = Epi::PERM ? ((R & ~31) + perm32(R & 31)) : R;
        voffA[i] = (unsigned)(R * K + C) * 2u; voffB[i] = (unsigned)(Rb * K + C) * 2u; }
    const size_t kstep = (size_t)(BK * 2);
    const size_t hstep = (size_t)HALF * K * 2;
    const size_t tstep = 2 * hstep;
    const unsigned ldsw = (unsigned)wid * 1024u;
    const int aoff = lds_byte(wr * 64 + fr, fq * 8), boff = lds_byte(wc * 32 + fr, fq * 8);
#define PG8_SA(b, h) (((b) * 2 + (h)) * HTB)
#define PG8_SB(b, h) ((4 + (b) * 2 + (h)) * HTB)
#define PG8_STAGE(bufoff, gbase, voff) do { _Pragma("unroll") for (int _i = 0; _i < 2; ++_i) \
        __builtin_amdgcn_global_load_lds((const unsigned*)((const char*)(gbase) + (voff)[_i]), (PG8_LAS unsigned*)(lds + (bufoff) + ldsw + _i * 8192), 16, 0, 0); } while (0)
#define PG8_LDA(dst, b, h) do { _Pragma("unroll") for (int m = 0; m < 4; ++m) _Pragma("unroll") for (int k = 0; k < 2; ++k) dst[m][k] = *(const PG8_LAS bf16x8*)(lds + PG8_SA(b, h) + aoff + m * 2048 + k * 1024); } while (0)
#define PG8_LDB(dst, b, h) do { _Pragma("unroll") for (int n = 0; n < 2; ++n) _Pragma("unroll") for (int k = 0; k < 2; ++k) dst[n][k] = *(const PG8_LAS bf16x8*)(lds + PG8_SB(b, h) + boff + n * 2048 + k * 1024); } while (0)
#define PG8_MMA(ai, bj, At, Bt) do { __builtin_amdgcn_s_setprio(1); _Pragma("unroll") for (int m = 0; m < 4; ++m) _Pragma("unroll") for (int n = 0; n < 2; ++n) _Pragma("unroll") for (int k = 0; k < 2; ++k) \
        acc[ai][bj][m][n] = __builtin_amdgcn_mfma_f32_16x16x32_bf16(Bt[n][k], At[m][k], acc[ai][bj][m][n], 0, 0, 0); __builtin_amdgcn_s_setprio(0); } while (0)
#define PG8_WAIT_V(n) asm volatile("s_waitcnt vmcnt(" #n ")" ::: "memory")
#define PG8_WAIT_L(n) asm volatile("s_waitcnt lgkmcnt(" #n ")" ::: "memory")
#define PG8_BAR __builtin_amdgcn_s_barrier()
#define PG8_SCHED __builtin_amdgcn_sched_barrier(0)
    Unit cur, nxt; int ui = 0;
    if (!S.next(0, cur)) return;
    f32x4 acc[2][2][4][2];
#pragma unroll
    for (int a = 0; a < 2; ++a)
#pragma unroll
        for (int b = 0; b < 2; ++b)
#pragma unroll
            for (int m = 0; m < 4; ++m)
#pragma unroll
                for (int n = 0; n < 2; ++n) acc[a][b][m][n] = (f32x4){0.f, 0.f, 0.f, 0.f};
    bf16x8 At[4][2], B0[2][2], B1[2][2];
    const char* cA = (const char*)g.A + (size_t)cur.pm * tstep; const char* cB = (const char*)g.Bt + (size_t)cur.pn * tstep;
    S.a_ready(cur);
    if constexpr (SP2) {
        PG8_STAGE(PG8_SB(0, 0), cB, voffB); PG8_STAGE(PG8_SB(0, 1), cB + hstep, voffB); PG8_STAGE(PG8_SA(0, 0), cA, voffA); PG8_STAGE(PG8_SA(0, 1), cA + hstep, voffA);
        if (wr == 1) PG8_BAR;
        PG8_WAIT_V(2); PG8_BAR;
        PG8_STAGE(PG8_SB(1, 0), cB + kstep, voffB); PG8_STAGE(PG8_SA(1, 0), cA + kstep, voffA); PG8_STAGE(PG8_SB(1, 1), cB + hstep + kstep, voffB);
        PG8_WAIT_V(6); PG8_BAR;
    } else {
        PG8_STAGE(PG8_SB(0, 0), cB, voffB); PG8_STAGE(PG8_SA(0, 0), cA, voffA); PG8_STAGE(PG8_SB(0, 1), cB + hstep, voffB); PG8_STAGE(PG8_SA(0, 1), cA + hstep, voffA);
        if (wr == 1) PG8_BAR;
        PG8_WAIT_V(4); PG8_BAR;
        PG8_STAGE(PG8_SB(1, 0), cB + kstep, voffB); PG8_STAGE(PG8_SA(1, 0), cA + kstep, voffA); PG8_STAGE(PG8_SB(1, 1), cB + hstep + kstep, voffB);
        PG8_WAIT_V(6); PG8_BAR;
    }
    for (;;) {
        const bool has_next = S.next(ui + 1, nxt);
        const char* nA = has_next ? (const char*)g.A + (size_t)nxt.pm * tstep : cA; const char* nB = has_next ? (const char*)g.Bt + (size_t)nxt.pn * tstep : cB;
        for (int t = 0; t < nt; t += 2) {
            const bool last = (t == nt - 2);
            const char* a1 = cA + (size_t)(t + 1) * kstep;
            const char* a2 = last ? nA : cA + (size_t)(t + 2) * kstep; const char* b2 = last ? nB : cB + (size_t)(t + 2) * kstep;
            const char* a3 = a2 + kstep; const char* b3 = b2 + kstep;
            if (last && has_next) S.a_ready(nxt);
            if constexpr (SP2) {
            PG8_LDB(B0, 0, 0); PG8_LDB(B1, 0, 1); PG8_SCHED; PG8_LDA(At, 0, 0); PG8_STAGE(PG8_SA(1, 1), a1 + hstep, voffA);
            PG8_WAIT_V(8); PG8_WAIT_L(0); PG8_BAR; PG8_MMA(0, 0, At, B0); PG8_MMA(0, 1, At, B1); PG8_BAR; PG8_SCHED;
            PG8_LDA(At, 0, 1); PG8_STAGE(PG8_SB(0, 0), b2, voffB); PG8_STAGE(PG8_SB(0, 1), b2 + hstep, voffB); PG8_STAGE(PG8_SA(0, 0), a2, voffA);
            PG8_WAIT_V(8); PG8_WAIT_L(0); PG8_BAR; PG8_MMA(1, 0, At, B0); PG8_MMA(1, 1, At, B1); PG8_BAR; PG8_SCHED;
            PG8_LDB(B0, 1, 0); PG8_LDB(B1, 1, 1); PG8_SCHED; PG8_LDA(At, 1, 0); PG8_STAGE(PG8_SA(0, 1), a2 + hstep, voffA);
            PG8_WAIT_V(8); PG8_WAIT_L(0); PG8_BAR; PG8_MMA(0, 0, At, B0); PG8_MMA(0, 1, At, B1); PG8_BAR; PG8_SCHED;
            PG8_LDA(At, 1, 1); PG8_STAGE(PG8_SB(1, 0), b3, voffB); PG8_STAGE(PG8_SB(1, 1), b3 + hstep, voffB); PG8_STAGE(PG8_SA(1, 0), a3, voffA);
            PG8_WAIT_V(8); PG8_WAIT_L(0); PG8_BAR; PG8_MMA(1, 0, At, B0); PG8_MMA(1, 1, At, B1); PG8_BAR; PG8_SCHED;
            } else {
            PG8_LDB(B0, 0, 0); PG8_SCHED; PG8_LDA(At, 0, 0); PG8_STAGE(PG8_SA(1, 1), a1 + hstep, voffA);
            PG8_WAIT_L(8); PG8_BAR; PG8_WAIT_L(0); PG8_MMA(0, 0, At, B0); PG8_BAR; PG8_SCHED;
            PG8_LDB(B1, 0, 1); PG8_STAGE(PG8_SB(0, 0), b2, voffB);
            PG8_BAR; PG8_WAIT_L(0); PG8_MMA(0, 1, At, B1); PG8_BAR;
            PG8_LDA(At, 0, 1); PG8_STAGE(PG8_SA(0, 0), a2, voffA);
            PG8_BAR; PG8_WAIT_L(0); PG8_MMA(1, 0, At, B0); PG8_BAR; PG8_SCHED;
            PG8_STAGE(PG8_SB(0, 1), b2 + hstep, voffB);
            PG8_WAIT_V(6); PG8_BAR; PG8_MMA(1, 1, At, B1); PG8_BAR;
            PG8_LDB(B0, 1, 0); PG8_SCHED; PG8_LDA(At, 1, 0); PG8_STAGE(PG8_SA(0, 1), a2 + hstep, voffA);
            PG8_WAIT_L(8); PG8_BAR; PG8_WAIT_L(0); PG8_MMA(0, 0, At, B0); PG8_BAR; PG8_SCHED;
            PG8_LDB(B1, 1, 1); PG8_STAGE(PG8_SB(1, 0), b3, voffB);
            PG8_BAR; PG8_WAIT_L(0); PG8_MMA(0, 1, At, B1); PG8_BAR;
            PG8_LDA(At, 1, 1); PG8_STAGE(PG8_SA(1, 0), a3, voffA);
            PG8_BAR; PG8_WAIT_L(0); PG8_MMA(1, 0, At, B0); PG8_BAR; PG8_SCHED;
            PG8_STAGE(PG8_SB(1, 1), b3 + hstep, voffB);
            PG8_WAIT_V(6); PG8_BAR; PG8_MMA(1, 1, At, B1); PG8_BAR;
            }
        }
        if constexpr (ALIGN_EPI) { if (wr == 0) PG8_BAR; }
        if constexpr (!Epi::AFTER_DRAIN) { E(acc, cur, wr, wc, fr, fq); S.done(cur); }
        if (!has_next) break;
#pragma unroll
        for (int a = 0; a < 2; ++a)
#pragma unroll
            for (int b = 0; b < 2; ++b)
#pragma unroll
                for (int m = 0; m < 4; ++m)
#pragma unroll
                    for (int n = 0; n < 2; ++n) acc[a][b][m][n] = (f32x4){0.f, 0.f, 0.f, 0.f};
        cur = nxt; cA = nA; cB = nB; ++ui;
        if constexpr (ALIGN_EPI) { if (wr == 1) PG8_BAR; }
    }
    PG8_WAIT_V(0);
    if constexpr (!ALIGN_EPI) { if (wr == 0) PG8_BAR; }
    PG8_BAR;
    if constexpr (Epi::AFTER_DRAIN) { E.fused(acc, cur, wr, wc, fr, fq, lds, wid, lane); S.done(cur); }
#undef PG8_SA
#undef PG8_SB
#undef PG8_STAGE
#undef PG8_LDA
#undef PG8_LDB
#undef PG8_MMA
#undef PG8_WAIT_V
#undef PG8_WAIT_L
#undef PG8_BAR
#undef PG8_SCHED
}
}

#ifndef MK_ALIGN
#define MK_ALIGN true
#endif
#ifndef MK_SP2
#define MK_SP2 true
#endif
#ifndef MK_STOP
#define MK_STOP N_PHASES
#endif
#ifndef MK_CHECK
#define MK_CHECK 0
#endif
#ifndef MK_DUPMASK
#define MK_DUPMASK 0
#endif
#ifndef MK_XSYNC
#define MK_XSYNC 0
#endif
#ifndef MK_MULTI
#define MK_MULTI 0
#endif
#define LAS __attribute__((address_space(3)))
typedef unsigned short bf16;
using pg8::f32x4; using pg8::bf16x8; using pg8::u32x4;
typedef unsigned u32x2 __attribute__((ext_vector_type(2)));

constexpr int NT = 16384, DM = 2048, FF = 5632, SEQ = 4096;
constexpr float EPS = 1e-6f;
constexpr size_t MiB = 1u << 20;
constexpr size_t WS_WGU = 2 * MiB, WS_WD = 178 * MiB, WS_WEIN = 266 * MiB, WS_WEOUT = 286 * MiB, WS_WOIN = 294 * MiB, WS_WOOUT = 306 * MiB,
                 WS_WGLU = 314 * MiB, WS_PWT = 316 * MiB, WS_HN = 318 * MiB, WS_MIX = 382 * MiB, WS_F = 446 * MiB, WS_BIG = 510 * MiB, WS_END = 686 * MiB;
constexpr size_t BIG_VT = 112 * MiB;
constexpr size_t BIG_VT2 = 64 * MiB, BIG_Y = 96 * MiB, BIG_E = 128 * MiB, BIG_RSTD = 136 * MiB;
constexpr int LDS_BYTES = 147456;
constexpr int N_PHASES = 25;
constexpr int CW_BAR = 4096;

struct Args { const float* in[24]; float* out; unsigned char* ws; int ph_lo, ph_hi;
#if MK_DUPMASK
  int dup_done, pad_;
#endif
};

__device__ __forceinline__ float bf_lo(unsigned x) { return __builtin_bit_cast(float, x << 16); }
__device__ __forceinline__ float bf_hi(unsigned x) { return __builtin_bit_cast(float, x & 0xffff0000u); }
typedef float f32x2_t __attribute__((ext_vector_type(2)));
typedef __bf16 bf16x2_t __attribute__((ext_vector_type(2)));
__device__ __forceinline__ unsigned pk2(float lo, float hi) { const f32x2_t v = {lo, hi}; const bf16x2_t b = __builtin_convertvector(v, bf16x2_t); return __builtin_bit_cast(unsigned, b); }
__device__ __forceinline__ float wave_sum(float v) {
#pragma unroll
    for (int o = 1; o < 64; o <<= 1) v += __shfl_xor(v, o);
    return v;
}
__device__ __forceinline__ f32x4 mfma16(bf16x8 a, bf16x8 b, f32x4 c) { return __builtin_amdgcn_mfma_f32_16x16x32_bf16(a, b, c, 0, 0, 0); }

#define XB_TMO      128
#define XB_XCNT(j)  (256  + 64 * (j))
#define XB_XSUB(j)  (1280 + 64 * (j))
#define XB_XGEN(j)  (2304 + 64 * (j))
#define XB_TOP      3328
#define XB_TOPGEN   3392
#define XCD_BAR_WORDS 3456
#define XB_SPIN_CAP (1u << 18)

__device__ __forceinline__ unsigned xb_ld(unsigned* p)              { return __hip_atomic_load(p, __ATOMIC_RELAXED, __HIP_MEMORY_SCOPE_AGENT); }
__device__ __forceinline__ unsigned xb_add(unsigned* p, unsigned v) { return __hip_atomic_fetch_add(p, v, __ATOMIC_RELAXED, __HIP_MEMORY_SCOPE_AGENT); }
__device__ __forceinline__ unsigned xb_xcc_id() { return (unsigned)__builtin_amdgcn_s_getreg((3 << 11) | 20) & 0xFu; }
#define XB_SPIN(cond, bar) do { unsigned _sp = 0; while (cond) { __builtin_amdgcn_s_sleep(1); \
    if ((++_sp & 255u) == 0u) { if (xb_ld(&(bar)[XB_TMO])) break; if (_sp > XB_SPIN_CAP) { atomicAdd(&(bar)[XB_TMO], 1u); break; } } } } while (0)

struct XcdBarrier {
    unsigned* bar; unsigned x;
    volatile LAS unsigned* st;
};

__device__ __forceinline__ XcdBarrier xcd_barrier_post(unsigned* bar, volatile LAS unsigned* st) {
    XcdBarrier b; b.bar = bar; b.x = xb_xcc_id(); b.st = st;
    if (threadIdx.x == 0) (void)xb_add(&bar[XB_XCNT(b.x)], 1u);
    return b;
}
__device__ __forceinline__ void xcd_barrier_complete(unsigned* bar, unsigned x, unsigned& nloc, unsigned& nx) {
    const unsigned G = gridDim.x * gridDim.y * gridDim.z;
    unsigned sum, cnt, mine, sp = 0u;
    for (;;) {
        sum = 0u; cnt = 0u; mine = 0u;
#pragma unroll
        for (unsigned j = 0; j < 16; ++j) { const unsigned c = xb_ld(&bar[XB_XCNT(j)]); sum += c; cnt += (c > 0u) ? 1u : 0u; mine = (j == x) ? c : mine; }
        if (sum == G) break;
        __builtin_amdgcn_s_sleep(1);
        if ((++sp & 255u) == 0u) { if (xb_ld(&bar[XB_TMO])) break; if (sp > XB_SPIN_CAP) { atomicAdd(&bar[XB_TMO], 1u); break; } }
    }
    nloc = mine > 0u ? mine : 1u; nx = cnt > 0u ? cnt : 1u;
}

__device__ __forceinline__ void xcd_barrier(const XcdBarrier& b) {
    asm volatile("s_waitcnt vmcnt(0)" ::: "memory");
    __syncthreads();
    if (threadIdx.x == 0) {
        unsigned* bar = b.bar;
        __builtin_amdgcn_s_waitcnt(0);
        unsigned nloc = b.st[0], nx = b.st[1];
        if (nloc == 0u) { xcd_barrier_complete(bar, b.x, nloc, nx); b.st[0] = nloc; b.st[1] = nx; }
        const unsigned old = xb_add(&bar[XB_XSUB(b.x)], 1u);
        const unsigned gen = old / nloc;
        if (old + 1u == (gen + 1u) * nloc) {
            __builtin_amdgcn_fence(__ATOMIC_RELEASE, "agent");
            asm volatile("s_waitcnt vmcnt(0)" ::: "memory");
            const unsigned og = xb_add(&bar[XB_TOP], 1u);
            const unsigned tg = og / nx;
            if (og + 1u == (tg + 1u) * nx) xb_add(&bar[XB_TOPGEN], 1u);
            else XB_SPIN(xb_ld(&bar[XB_TOPGEN]) == tg, bar);
            __builtin_amdgcn_fence(__ATOMIC_ACQUIRE, "agent");
            xb_add(&bar[XB_XGEN(b.x)], 1u);
            asm volatile("s_waitcnt vmcnt(0)" ::: "memory");
        } else {
            XB_SPIN(xb_ld(&bar[XB_XGEN(b.x)]) == gen, bar);
            __builtin_amdgcn_fence(__ATOMIC_ACQUIRE, "agent");
            asm volatile("s_waitcnt vmcnt(0)" ::: "memory");
        }
    }
    __syncthreads();
}

__device__ __forceinline__ void transpose_item(const float* W, int K, int N, bf16* WT, int item, LAS float* scr, int lane, int mode) {
    const int nblk = N / 32, kb = item / nblk, nb = item % nblk, k0 = 64 * kb, n0 = 32 * nb;
    int d0 = n0; if (mode) d0 = (n0 >> 7) * 256 + (n0 & 127) + (mode == 2 ? 128 : 0);
    { f32x4 v[8];
#pragma unroll
      for (int i = 0; i < 8; ++i) v[i] = __builtin_nontemporal_load((const f32x4*)(W + (size_t)(k0 + 8 * i + (lane >> 3)) * N + n0 + 4 * (lane & 7)));
#pragma unroll
      for (int i = 0; i < 8; ++i) { LAS float* d = scr + (8 * i + (lane >> 3)) * 33 + 4 * (lane & 7); d[0] = v[i][0]; d[1] = v[i][1]; d[2] = v[i][2]; d[3] = v[i][3]; } }
    asm volatile("s_waitcnt lgkmcnt(0)" ::: "memory");
    const int c = lane & 7;
#pragma unroll
    for (int j = 0; j < 4; ++j) { const int n = (lane >> 3) + 8 * j; const LAS float* s = scr + (8 * c) * 33 + n;
        u32x4 o; o.x = pk2(s[0 * 33], s[1 * 33]); o.y = pk2(s[2 * 33], s[3 * 33]); o.z = pk2(s[4 * 33], s[5 * 33]); o.w = pk2(s[6 * 33], s[7 * 33]);
        *(u32x4*)(WT + (size_t)(d0 + n) * K + k0 + 8 * c) = o; }
    asm volatile("s_waitcnt lgkmcnt(0)" ::: "memory");
}

__device__ __forceinline__ void phase_conv(const Args& a, LAS unsigned char* lds, int gw, int NGW, int wave, int lane) {
    LAS float* scr = (LAS float*)(lds + wave * 16384);
    unsigned char* ws = a.ws;
    constexpr int I_G = 32 * 176, I_D = 88 * 64, I_EIN = 32 * 160, I_SQ = 32 * 64, I_OIN = 32 * 96, I_GLU = 16 * 32, I_P = 2 * 4;
    constexpr int NITEMS = 8 * I_G + 4 * I_D + I_EIN + 2 * I_SQ + I_OIN + I_GLU + 4 * I_P;
    for (int it = gw; it < NITEMS; it += NGW) {
        int r = it;
        if (r < 8 * I_G) { const int m = r / I_G; r -= m * I_G; const int lf = m >> 1, up = m & 1;
            transpose_item((up ? a.in[3] : a.in[2]) + (size_t)lf * DM * FF, DM, FF, (bf16*)(ws + WS_WGU) + (size_t)lf * 11264 * 2048, r, scr, lane, 1 + up); continue; }
        r -= 8 * I_G;
        if (r < 4 * I_D) { const int lf = r / I_D; r -= lf * I_D;
            transpose_item(a.in[4] + (size_t)lf * FF * DM, FF, DM, (bf16*)(ws + WS_WD) + (size_t)lf * 2048 * 5632, r, scr, lane, 0); continue; }
        r -= 4 * I_D;
        if (r < I_EIN) { transpose_item(a.in[5], DM, 5120, (bf16*)(ws + WS_WEIN), r, scr, lane, 0); continue; } r -= I_EIN;
        if (r < I_SQ) { transpose_item(a.in[8], DM, DM, (bf16*)(ws + WS_WEOUT), r, scr, lane, 0); continue; } r -= I_SQ;
        if (r < I_SQ) { transpose_item(a.in[23], DM, DM, (bf16*)(ws + WS_WOOUT), r, scr, lane, 0); continue; } r -= I_SQ;
        if (r < I_OIN) { transpose_item(a.in[9], DM, 3072, (bf16*)(ws + WS_WOIN), r, scr, lane, 0); continue; } r -= I_OIN;
        if (r < I_GLU) { transpose_item(a.in[18], 1024, 1024, (bf16*)(ws + WS_WGLU), r, scr, lane, 0); continue; } r -= I_GLU;
        { const int g = r / I_P; r -= g * I_P; transpose_item(a.in[6] + (size_t)g * 128 * 128, 128, 128, (bf16*)(ws + WS_PWT) + (size_t)g * 128 * 128, r, scr, lane, 0); }
    }
}

__device__ __forceinline__ void phase_row(const float* xsrc, const bf16* Fb, const float* gF, float alpha, float* xdst, const float* gH, bf16* HN, int gw, int NGW, int lane) {
    for (int m = gw; m < NT; m += NGW) {
        const f32x4* xr = (const f32x4*)(xsrc + (size_t)m * DM) + lane;
        f32x4 v[8];
#pragma unroll
        for (int j = 0; j < 8; ++j) v[j] = xr[64 * j];
        if (Fb) {
            const u32x2* fp = (const u32x2*)(Fb + (size_t)m * DM) + lane;
            f32x4 f[8]; float s = 0.f;
#pragma unroll
            for (int j = 0; j < 8; ++j) { const u32x2 p = fp[64 * j]; f[j] = (f32x4){bf_lo(p.x), bf_hi(p.x), bf_lo(p.y), bf_hi(p.y)};
                s += (f[j][0] * f[j][0] + f[j][1] * f[j][1]) + (f[j][2] * f[j][2] + f[j][3] * f[j][3]); }
            const float rs = alpha / sqrtf(wave_sum(s) * (1.f / DM) + EPS);
            f32x4* xo = (f32x4*)(xdst + (size_t)m * DM) + lane;
#pragma unroll
            for (int j = 0; j < 8; ++j) { const f32x4 g = ((const f32x4*)gF)[64 * j + lane]; v[j] = v[j] + f[j] * g * rs; xo[64 * j] = v[j]; }
        }
        if (gH) {
            float s = 0.f;
#pragma unroll
            for (int j = 0; j < 8; ++j) s += (v[j][0] * v[j][0] + v[j][1] * v[j][1]) + (v[j][2] * v[j][2] + v[j][3] * v[j][3]);
            const float rs = 1.f / sqrtf(wave_sum(s) * (1.f / DM) + EPS);
            u32x2* ho = (u32x2*)(HN + (size_t)m * DM) + lane;
#pragma unroll
            for (int j = 0; j < 8; ++j) { const f32x4 g = ((const f32x4*)gH)[64 * j + lane]; const f32x4 y = v[j] * g * rs;
                ho[64 * j] = (u32x2){pk2(y[0], y[1]), pk2(y[2], y[3])}; }
        }
    }
}

__device__ __forceinline__ void pool_item(const Args& a, const bf16* P, const bf16* PWT, bf16* MIX, int item, int wave, int lane) {
    const int fr = lane & 15, fq = lane >> 4;
    const int g = item & 3, tt = item >> 2;
    const int tok = tt * 128 + wave * 16 + fr, tpos = tok & (SEQ - 1), Wn = 2 << g;
    const int nwin = (tpos + 1 < Wn) ? tpos + 1 : Wn;
    const float inv = 1.0f / (float)nwin;
    bf16x8 af[4];
#pragma unroll
    for (int kk = 0; kk < 4; ++kk) {
        const bf16* p = P + (size_t)tok * 3584 + g * 128 + kk * 32 + fq * 8;
        float s[8];
#pragma unroll
        for (int e = 0; e < 8; ++e) s[e] = 0.f;
        const u32x4 own = *(const u32x4*)p;
        u32x4 rr[15];
#pragma unroll
        for (int d = 1; d < 16; ++d) if (d < Wn) { const int dd = (d <= tpos) ? d : 0; rr[d - 1] = *(const u32x4*)(p - (size_t)dd * 3584); }
#pragma unroll
        for (int e = 0; e < 4; ++e) { s[2 * e] = bf_lo(own[e]); s[2 * e + 1] = bf_hi(own[e]); }
#pragma unroll
        for (int d = 1; d < 16; ++d) if (d < Wn) { const float m = (d <= tpos) ? 1.f : 0.f;
#pragma unroll
            for (int e = 0; e < 4; ++e) { s[2 * e] += m * bf_lo(rr[d - 1][e]); s[2 * e + 1] += m * bf_hi(rr[d - 1][e]); } }
        u32x4 o;
#pragma unroll
        for (int e = 0; e < 4; ++e) o[e] = pk2(s[2 * e] * inv - bf_lo(own[e]), s[2 * e + 1] * inv - bf_hi(own[e]));
        af[kk] = __builtin_bit_cast(bf16x8, o);
    }
    const float* scale = a.in[7];
#pragma unroll
    for (int nt = 0; nt < 8; ++nt) {
        f32x4 acc = (f32x4){0.f, 0.f, 0.f, 0.f};
#pragma unroll
        for (int kk = 0; kk < 4; ++kk) { const bf16x8 wf = *(const bf16x8*)(PWT + ((size_t)(g * 128 + nt * 16 + fr)) * 128 + kk * 32 + fq * 8); acc = mfma16(wf, af[kk], acc); }
        const int c = g * 128 + nt * 16 + 4 * fq; const f32x4 sc = *(const f32x4*)(scale + c);
        *(u32x2*)(MIX + (size_t)tok * DM + c) = (u32x2){pk2(acc[0] * sc[0], acc[1] * sc[1]), pk2(acc[2] * sc[2], acc[3] * sc[3])};
    }
}

constexpr int AK_PITCH = 272, AV_PITCH = 80, AK_BYTES = 32 * AK_PITCH, AV_BYTES = 128 * AV_PITCH, ABUF = AK_BYTES + AV_BYTES, AFLAG_OFF = 2 * ABUF;
__device__ __forceinline__ void attn_wg_item(const bf16* P, const bf16* VT, bf16* MIX, LAS unsigned char* lds, int item, int wave, int lane, int tid) {
    const int fr = lane & 15, fq = lane >> 4;
    const int qblk = item & 31, bh = item >> 5, h = bh % 12, b = bh / 12;
    const int q0b = qblk * 128, q0 = q0b + wave * 16, t = q0 + fr; const size_t tokb = (size_t)b * SEQ;
    bf16x8 qf[4];
#pragma unroll
    for (int kk = 0; kk < 4; ++kk) qf[kk] = *(const bf16x8*)(P + (tokb + t) * 3584 + 512 + h * 128 + kk * 32 + fq * 8);
    f32x4 o[8];
#pragma unroll
    for (int dt = 0; dt < 8; ++dt) o[dt] = (f32x4){0.f, 0.f, 0.f, 0.f};
    float R = 0.f; bool done = false;
    const int krow = tid >> 4, kch = tid & 15, vrow = tid >> 2, vch = tid & 3;
    const bf16* kg = P + (tokb + krow) * 3584 + 2048 + h * 128 + kch * 8;
    const bf16* vg = VT + (size_t)(h * 128 + vrow) * NT + tokb + vch * 8;
    int kt = (q0b + 127) >> 5;
    u32x4 kr = *(const u32x4*)(kg + (size_t)(kt * 32) * 3584), vr = *(const u32x4*)(vg + kt * 32);
    for (;;) {
        LAS unsigned char* buf = lds + (kt & 1) * ABUF;
        volatile LAS unsigned* flg = (volatile LAS unsigned*)(lds + AFLAG_OFF + (kt & 1) * 64);
        *(LAS u32x4*)(buf + krow * AK_PITCH + kch * 16) = kr;
        *(LAS u32x4*)(buf + AK_BYTES + vrow * AV_PITCH + vch * 16) = vr;
        if (lane == 0) flg[wave] = done ? 1u : 0u;
        if (kt > 0) { kr = *(const u32x4*)(kg + (size_t)((kt - 1) * 32) * 3584); vr = *(const u32x4*)(vg + (kt - 1) * 32); }
        __syncthreads();
        unsigned alld = 1u;
#pragma unroll
        for (int w = 0; w < 8; ++w) alld &= flg[w];
        if (alld) break;
        const int s0 = kt * 32;
        if (!done && s0 <= q0 + 14) {
            f32x4 z[2]; z[0] = (f32x4){0.f, 0.f, 0.f, 0.f}; z[1] = z[0];
#pragma unroll
            for (int kk = 0; kk < 4; ++kk) { const bf16x8 k0 = *(const LAS bf16x8*)(buf + fr * AK_PITCH + kk * 64 + fq * 16), k1 = *(const LAS bf16x8*)(buf + (16 + fr) * AK_PITCH + kk * 64 + fq * 16);
                z[0] = mfma16(k0, qf[kk], z[0]); z[1] = mfma16(k1, qf[kk], z[1]); }
            float lsp[2][4], lk[2][4], tot[2];
#pragma unroll
            for (int sub = 0; sub < 2; ++sub) { tot[sub] = 0.f;
#pragma unroll
                for (int r = 0; r < 4; ++r) { const int key = s0 + sub * 16 + 4 * fq + r; const bool valid = key < t;
                    const float zz = z[sub][r] * 0.08838834764831845f;
                    const float l1p = __logf(1.0f + __expf(-fabsf(zz)));
                    lsp[sub][r] = valid ? (fminf(zz, 0.f) - l1p) : -1e30f;
                    lk[sub][r] = valid ? -(fmaxf(zz, 0.f) + l1p) : 0.f;
                    tot[sub] += lk[sub][r]; } }
            float G[2], TT[2];
#pragma unroll
            for (int sub = 0; sub < 2; ++sub) {
                const float a1 = __shfl_down(tot[sub], 16), a2 = __shfl_down(tot[sub], 32), a3 = __shfl_down(tot[sub], 48);
                G[sub] = (fq < 3 ? a1 : 0.f) + (fq < 2 ? a2 : 0.f) + (fq < 1 ? a3 : 0.f);
                const float t1 = tot[sub] + __shfl_xor(tot[sub], 16); TT[sub] = t1 + __shfl_xor(t1, 32);
            }
            float w[2][4];
#pragma unroll
            for (int sub = 0; sub < 2; ++sub) { float later = R + G[sub] + (sub == 0 ? TT[1] : 0.f);
#pragma unroll
                for (int r = 3; r >= 0; --r) { w[sub][r] = __expf(lsp[sub][r] + later); later += lk[sub][r]; } }
            u32x4 wp; wp.x = pk2(w[0][0], w[0][1]); wp.y = pk2(w[0][2], w[0][3]); wp.z = pk2(w[1][0], w[1][1]); wp.w = pk2(w[1][2], w[1][3]);
            const bf16x8 wf = __builtin_bit_cast(bf16x8, wp);
            const LAS unsigned char* vb = buf + AK_BYTES + fr * AV_PITCH + fq * 8;
#pragma unroll
            for (int dt = 0; dt < 8; ++dt) { const u32x2 v0 = *(const LAS u32x2*)(vb + dt * 16 * AV_PITCH), v1 = *(const LAS u32x2*)(vb + dt * 16 * AV_PITCH + 32);
                const u32x4 vv = (u32x4){v0.x, v0.y, v1.x, v1.y};
                o[dt] = mfma16(__builtin_bit_cast(bf16x8, vv), wf, o[dt]); }
            R += TT[0] + TT[1];
            if (__all(R < -110.f)) done = true;
        }
        if (kt == 0) break;
        --kt;
    }
    __syncthreads();
    bf16* op = MIX + (tokb + t) * DM + 512 + h * 128 + 4 * fq;
#pragma unroll
    for (int dt = 0; dt < 8; ++dt) *(u32x2*)(op + dt * 16) = (u32x2){pk2(o[dt][0], o[dt][1]), pk2(o[dt][2], o[dt][3])};
}

__device__ __forceinline__ void sincos_f(float x, float& s, float& c) {
    const float k = rintf(x * 0.6366197723675814f);
    float r = fmaf(-k, 1.5707962513e+00f, x); r = fmaf(-k, 7.5497894159e-08f, r);
    const float r2 = r * r;
    const float sp = r + r * r2 * (-1.6666654611e-1f + r2 * (8.3321608736e-3f + r2 * (-1.9515295891e-4f)));
    const float cp = 1.0f - 0.5f * r2 + r2 * r2 * (4.166664568298827e-2f + r2 * (-1.388731625493765e-3f + r2 * 2.443315711809948e-5f));
    const int q = ((int)k) & 3;
    s = (q == 0) ? sp : (q == 1) ? cp : (q == 2) ? -sp : -cp;
    c = (q == 0) ? cp : (q == 1) ? -sp : (q == 2) ? -cp : sp;
}

typedef float f2v __attribute__((ext_vector_type(2)));
constexpr int SSM_ROWB = 272, SSM_TILEB = 64 * SSM_ROWB;
template <bool OUT>
__device__ __forceinline__ void ssm_item(const Args& a, const bf16* Podd, float2* E, bf16* Y, LAS unsigned char* lds, int item, int wave, int lane) {
    const int g = item & 63, c = (item >> 6) & 63, b = item >> 12, n = lane;
    const float dt = expf(a.in[12][g]);
    const float are = a.in[10][g * 64 + n], aim = a.in[11][g * 64 + n];
    const float mag = expf(are * dt); float sn, cs; sincos_f(aim * dt, sn, cs);
    const float lr = mag * cs, li = mag * sn;
    const float den = are * are + aim * aim, nr = lr - 1.0f;
    const float fre = (nr * are + li * aim) / den, fim = (li * are - nr * aim) / den;
    f2v bb[16];
    { const f32x4* br = (const f32x4*)(a.in[13] + (size_t)(g * 64 + n) * 16); const f32x4* bi = (const f32x4*)(a.in[14] + (size_t)(g * 64 + n) * 16);
#pragma unroll
      for (int q = 0; q < 4; ++q) { const f32x4 x = br[q], y = bi[q];
#pragma unroll
          for (int i = 0; i < 4; ++i) bb[4 * q + i] = (f2v){fre * x[i] - fim * y[i], fre * y[i] + fim * x[i]}; } }
    const size_t tok0 = (size_t)b * SEQ + c * 64;
    const int fr = lane & 15, fq = lane >> 4;
    LAS unsigned char* tile = lds + wave * SSM_TILEB;
    LAS unsigned* Sw = (LAS unsigned*)tile;
    { u32x4 w;
      w = (u32x4){pk2(bb[0].x, bb[1].x), pk2(bb[2].x, bb[3].x), pk2(bb[4].x, bb[5].x), pk2(bb[6].x, bb[7].x)};         *(LAS u32x4*)(tile + (2 * n) * 32) = w;
      w = (u32x4){pk2(bb[8].x, bb[9].x), pk2(bb[10].x, bb[11].x), pk2(bb[12].x, bb[13].x), pk2(bb[14].x, bb[15].x)};   *(LAS u32x4*)(tile + (2 * n) * 32 + 16) = w;
      w = (u32x4){pk2(bb[0].y, bb[1].y), pk2(bb[2].y, bb[3].y), pk2(bb[4].y, bb[5].y), pk2(bb[6].y, bb[7].y)};         *(LAS u32x4*)(tile + (2 * n + 1) * 32) = w;
      w = (u32x4){pk2(bb[8].y, bb[9].y), pk2(bb[10].y, bb[11].y), pk2(bb[12].y, bb[13].y), pk2(bb[14].y, bb[15].y)};   *(LAS u32x4*)(tile + (2 * n + 1) * 32 + 16) = w; }
    bf16x8 ub[4], af[8];
    const bf16x8 zero8 = (bf16x8){0, 0, 0, 0, 0, 0, 0, 0};
#pragma unroll
    for (int tt = 0; tt < 4; ++tt) ub[tt] = (fq < 2) ? *(const bf16x8*)(Podd + (tok0 + tt * 16 + fr) * 2048 + g * 16 + 8 * fq) : zero8;
#pragma unroll
    for (int nt = 0; nt < 8; ++nt) af[nt] = (fq < 2) ? *(const LAS bf16x8*)(tile + (nt * 16 + fr) * 32 + fq * 16) : zero8;
    float sr = 0.f, si = 0.f;
    if (OUT) {
        float pr = lr, pi = li;
#pragma unroll
        for (int q = 0; q < 6; ++q) { const float tr = pr * pr - pi * pi; pi = 2.f * pr * pi; pr = tr; }
        const float2* Ep = E + ((size_t)(b * 64) * 64 + g) * 64 + n;
        for (int c0 = 0; c0 < c; c0 += 16) {
            float2 e[16];
#pragma unroll
            for (int k = 0; k < 16; ++k) { const int cc = (c0 + k < c) ? c0 + k : c - 1; e[k] = Ep[(size_t)cc * 4096]; }
#pragma unroll
            for (int k = 0; k < 16; ++k) if (c0 + k < c) { const float tr = pr * sr - pi * si + e[k].x; si = pr * si + pi * sr + e[k].y; sr = tr; }
        }
    }
#pragma unroll
    for (int tt = 0; tt < 4; ++tt)
#pragma unroll
        for (int nt = 0; nt < 8; ++nt) { const f32x4 d = mfma16(af[nt], ub[tt], (f32x4){0.f, 0.f, 0.f, 0.f});
            *(LAS u32x2*)(tile + (tt * 16 + fr) * SSM_ROWB + (nt * 16 + 4 * fq) * 2) = (u32x2){pk2(d[0], d[1]), pk2(d[2], d[3])}; }
    f2v s = (f2v){sr, si};
    const f2v lam_a = (f2v){lr, lr}, lam_b = (f2v){-li, li};
    for (int t0 = 0; t0 < 64; t0 += 8) {
        unsigned bw[8];
#pragma unroll
        for (int k = 0; k < 8; ++k) bw[k] = Sw[(t0 + k) * (SSM_ROWB / 4) + n];
#pragma unroll
        for (int k = 0; k < 8; ++k) { const f2v bu = (f2v){bf_lo(bw[k]), bf_hi(bw[k])};
            s = lam_a * s + (lam_b * (f2v){s.y, s.x} + bu);
            if (OUT) Sw[(t0 + k) * (SSM_ROWB / 4) + n] = pk2(s.x, s.y); }
    }
    if (!OUT) { E[((size_t)(b * 64 + c) * 64 + g) * 64 + n] = make_float2(s.x, s.y); }
    else {
        bf16x8 cf[4];
#pragma unroll
        for (int kk = 0; kk < 4; ++kk) { const size_t off = (size_t)(g * 16 + fr) * 64 + kk * 16 + 4 * fq;
            const f32x4 cr = *(const f32x4*)(a.in[15] + off), ci = *(const f32x4*)(a.in[16] + off);
            const u32x4 w = (u32x4){pk2(cr[0], -ci[0]), pk2(cr[1], -ci[1]), pk2(cr[2], -ci[2]), pk2(cr[3], -ci[3])};
            cf[kk] = __builtin_bit_cast(bf16x8, w); }
        const f32x4 dsk = *(const f32x4*)(a.in[17] + g * 16 + 4 * fq);
        const LAS unsigned char* Sr = lds + wave * SSM_TILEB + fr * SSM_ROWB + fq * 16;
#pragma unroll
        for (int tt = 0; tt < 4; ++tt) {
            f32x4 acc = (f32x4){0.f, 0.f, 0.f, 0.f};
#pragma unroll
            for (int kk = 0; kk < 4; ++kk) { const bf16x8 sf = *(const LAS bf16x8*)(Sr + tt * 16 * SSM_ROWB + kk * 64); acc = mfma16(cf[kk], sf, acc); }
            const size_t tok = tok0 + tt * 16 + fr;
            const u32x2 uu = *(const u32x2*)(Podd + tok * 2048 + g * 16 + 4 * fq);
            const float y0 = pg8::gelu_f(acc[0] + dsk[0] * bf_lo(uu.x)), y1 = pg8::gelu_f(acc[1] + dsk[1] * bf_hi(uu.x));
            const float y2 = pg8::gelu_f(acc[2] + dsk[2] * bf_lo(uu.y)), y3 = pg8::gelu_f(acc[3] + dsk[3] * bf_hi(uu.y));
            *(u32x2*)(Y + tok * 1024 + g * 16 + 4 * fq) = (u32x2){pk2(y0, y1), pk2(y2, y3)};
        }
    }
}

__device__ __forceinline__ void rowstat_item(const bf16* VT2, float* RSTD, LAS float* red, int item, int wave, int lane) {
    const int tok = item * 64 + lane;
    const bf16* p = VT2 + (size_t)(wave * 128) * NT + tok;
    float s = 0.f;
#pragma unroll 16
    for (int c = 0; c < 128; ++c) { const float v = bf_lo((unsigned)p[(size_t)c * NT]); s = fmaf(v, v, s); }
    red[wave * 64 + lane] = s;
    __syncthreads();
    if (wave == 0) { float tsum = 0.f;
#pragma unroll
        for (int w = 0; w < 8; ++w) tsum += red[w * 64 + lane];
        RSTD[tok] = 1.f / sqrtf(tsum * (1.f / 1024.f) + EPS); }
    __syncthreads();
}
__device__ __forceinline__ void sgu_item(const Args& a, const bf16* Podd, const bf16* VT2, const float* RSTD, bf16* MIX, int item, int wave, int lane) {
    const int fr = lane & 15, fq = lane >> 4;
    const int h = item & 7, nb = item >> 3, tok0 = nb * 128, trow = wave * 16 + fr;
    f32x4 acc[8];
#pragma unroll
    for (int dt = 0; dt < 8; ++dt) acc[dt] = (f32x4){0.f, 0.f, 0.f, 0.f};
    const int nk = (wave * 16 + 15) / 32 + 1;
    const float* sw = a.in[21] + ((size_t)h * 128 + trow) * 128 + fq * 8;
    for (int kk = 0; kk < nk; ++kk) {
        const f32x4 w0 = *(const f32x4*)(sw + kk * 32), w1 = *(const f32x4*)(sw + kk * 32 + 4);
        const f32x4 r0 = *(const f32x4*)(RSTD + tok0 + kk * 32 + fq * 8), r1 = *(const f32x4*)(RSTD + tok0 + kk * 32 + fq * 8 + 4);
        float wv[8];
#pragma unroll
        for (int e = 0; e < 4; ++e) { const int s = kk * 32 + fq * 8 + e; wv[e] = (s <= trow) ? w0[e] * r0[e] : 0.f; wv[4 + e] = (s + 4 <= trow) ? w1[e] * r1[e] : 0.f; }
        u32x4 wp; wp.x = pk2(wv[0], wv[1]); wp.y = pk2(wv[2], wv[3]); wp.z = pk2(wv[4], wv[5]); wp.w = pk2(wv[6], wv[7]);
        const bf16x8 wf = __builtin_bit_cast(bf16x8, wp);
        const bf16* vp = VT2 + (size_t)(h * 128 + fr) * NT + tok0 + kk * 32 + fq * 8;
#pragma unroll
        for (int dt = 0; dt < 8; ++dt) { const bf16x8 vf = *(const bf16x8*)(vp + (size_t)dt * 16 * NT); acc[dt] = mfma16(vf, wf, acc[dt]); }
    }
    const float bs = a.in[22][h * 128 + trow];
    const size_t tok = (size_t)tok0 + trow;
#pragma unroll
    for (int dt = 0; dt < 8; ++dt) { const int d = h * 128 + dt * 16 + 4 * fq;
        const f32x4 gn = *(const f32x4*)(a.in[20] + d);
        const u32x2 uu = *(const u32x2*)(Podd + tok * 2048 + 1024 + d);
        const float o0 = bf_lo(uu.x) * (gn[0] * acc[dt][0] + bs), o1 = bf_hi(uu.x) * (gn[1] * acc[dt][1] + bs);
        const float o2 = bf_lo(uu.y) * (gn[2] * acc[dt][2] + bs), o3 = bf_hi(uu.y) * (gn[3] * acc[dt][3] + bs);
        *(u32x2*)(MIX + tok * DM + 1024 + d) = (u32x2){pk2(o0, o1), pk2(o2, o3)}; }
}

__global__ void __launch_bounds__(512, 2) fwd(Args a) {
    extern __shared__ __attribute__((aligned(16))) unsigned char lds_raw[];
    LAS unsigned char* lds = (LAS unsigned char*)lds_raw;
    cg::grid_group grid = cg::this_grid();
    const int G = gridDim.x, bx = blockIdx.x, NGW = G * 8;
    unsigned char* ws = a.ws;
    bf16* const HN = (bf16*)(ws + WS_HN); bf16* const MIX = (bf16*)(ws + WS_MIX); bf16* const Fb = (bf16*)(ws + WS_F); bf16* const BIG = (bf16*)(ws + WS_BIG);
    bf16* const VT = (bf16*)(ws + WS_BIG + BIG_VT); bf16* const VT2 = (bf16*)(ws + WS_BIG + BIG_VT2); bf16* const Yb = (bf16*)(ws + WS_BIG + BIG_Y);
    float2* const Eb = (float2*)(ws + WS_BIG + BIG_E); float* const RSTD = (float*)(ws + WS_BIG + BIG_RSTD);
    const float* normg = a.in[1];
    volatile LAS unsigned* MISC = (volatile LAS unsigned*)(lds + LDS_BYTES - 64);
    if (threadIdx.x < 16) MISC[threadIdx.x] = 0u;
    __syncthreads();
    XcdBarrier xbar; xbar.bar = (unsigned*)ws + CW_BAR; xbar.x = 0; xbar.st = nullptr;
    if (a.ph_hi - a.ph_lo > 1) xbar = xcd_barrier_post((unsigned*)ws + CW_BAR, MISC);

    for (int ph = a.ph_lo; ph < a.ph_hi; ++ph) {
        bool did = true;
        int tid_ = threadIdx.x; asm volatile("" : "+v"(tid_));
        const int lane = tid_ & 63, wave = __builtin_amdgcn_readfirstlane(tid_ >> 6), gw = bx * 8 + wave;
        if (ph == 0) {
#ifndef NO_CONV
            phase_conv(a, lds, gw, NGW, wave, lane);
#endif
            phase_row(a.in[0], nullptr, nullptr, 0.f, nullptr, normg, HN, gw, NGW, lane);
        } else {
            const int i = (ph - 1) / 12, s = (ph - 1) % 12;
            const float* ng = normg + (size_t)i * 6 * DM;
            if (s == 0 || s == 9) {
                const int lf = i * 2 + (s == 9);
                pg8::Gemm g{HN, (const bf16*)(ws + WS_WGU) + (size_t)lf * 11264 * 2048, NT, 11264, DM}; pg8::StaticOrder S; S.init(NT, 11264, G, bx);
                pg8::EpiSwiglu E{BIG, FF};
#ifndef NO_G1
                pg8::gemm_phase<pg8::EpiSwiglu, pg8::StaticOrder, MK_ALIGN, MK_SP2>(lds, g, S, E);
#endif
            } else if (s == 1 || s == 10 || s == 7) {
                const int lf = i * 2 + (s == 10);
                const bf16* A = (s == 7) ? MIX : BIG; const int K = (s == 7) ? DM : FF;
                const bf16* Bt = (s == 7) ? (const bf16*)(ws + (i == 0 ? WS_WEOUT : WS_WOOUT)) : (const bf16*)(ws + WS_WD) + (size_t)lf * 2048 * 5632;
                pg8::Gemm g{A, Bt, NT, DM, K}; pg8::StaticOrder S; S.init(NT, DM, G, bx);
                pg8::EpiBf16<0> E{Fb, DM, nullptr, 0, 0, 1.f};
#ifndef NO_G2
                pg8::gemm_phase<pg8::EpiBf16<0>, pg8::StaticOrder, MK_ALIGN, MK_SP2>(lds, g, S, E);
#endif
            } else if (s == 2 || s == 8 || s == 11) {
                const int kf = (s == 2) ? 1 : (s == 8) ? 3 : 5;
                const float* gH = (s == 11) ? (i == 0 ? normg + 6 * DM : nullptr) : ng + (size_t)(kf + 1) * DM;
                const float* xsrc = (ph == 3) ? a.in[0] : a.out;
                phase_row(xsrc, Fb, ng + (size_t)kf * DM, (s == 8) ? 1.0f : 0.5f, a.out, gH, HN, gw, NGW, lane);
            } else if (s == 3) {
                const int N = (i == 0) ? 5120 : 3072;
                pg8::Gemm g{HN, (const bf16*)(ws + (i == 0 ? WS_WEIN : WS_WOIN)), NT, N, DM}; pg8::StaticOrder S; S.init(NT, N, G, bx);
                pg8::EpiIn E{BIG, (i == 0) ? 3584 : 2048, (i == 0) ? VT : VT2, NT, (i == 0) ? 3584 : 2048, (i == 0) ? (1 << 30) : 1024};
#ifndef NO_G3
                pg8::gemm_phase<pg8::EpiIn, pg8::StaticOrder, MK_ALIGN, MK_SP2>(lds, g, S, E);
#endif
            } else if (s == 4) {
                if (i == 0) {
#ifndef NO_POOL
                    for (int it = bx; it < 512; it += G) pool_item(a, BIG, (const bf16*)(ws + WS_PWT), MIX, it, wave, lane);
                    for (int it = bx; it < 4 * 12 * 32; it += G) attn_wg_item(BIG, VT, MIX, lds, it, wave, lane, tid_);
#endif
                } else {
#ifndef NO_SSM
                    for (int it = bx; it < 256; it += G) rowstat_item(VT2, RSTD, (LAS float*)lds, it, wave, lane);
                    for (int it = gw; it < 4 * 64 * 64; it += NGW) ssm_item<false>(a, BIG, Eb, Yb, lds, it, wave, lane);
#endif
                }
            } else if (s == 5) {
                if (i == 1) {
#ifndef NO_SSM3
                    for (int it = bx; it < 1024; it += G) sgu_item(a, BIG, VT2, RSTD, MIX, it, wave, lane);
                    for (int it = gw; it < 4 * 64 * 64; it += NGW) ssm_item<true>(a, BIG, Eb, Yb, lds, it, wave, lane);
#endif
                } else did = false;
            } else {
                if (i == 1) {
                    pg8::Gemm g{Yb, (const bf16*)(ws + WS_WGLU), NT, 1024, 1024}; pg8::StaticOrder S; S.init(NT, 1024, G, bx);
                    pg8::EpiGlu E{Yb, 1024, a.in[19], MIX, DM};
#ifndef NO_G4
                    pg8::gemm_phase<pg8::EpiGlu, pg8::StaticOrder, MK_ALIGN, MK_SP2>(lds, g, S, E);
#endif
                } else did = false;
            }
        }
        if (did && ph + 1 < a.ph_hi) { if (a.ph_hi > N_PHASES) grid.sync(); else xcd_barrier(xbar); }
#if MK_XSYNC
        if (ph >= 1 && ph <= 5) { for (int q = 0; q < 4; ++q) grid.sync(); }
#endif
#if MK_DUPMASK
        if (!(a.dup_done) && ((MK_DUPMASK >> ph) & 1)) { a.dup_done = 1; --ph; } else a.dup_done = 0;
#endif
    }
}


#if MK_CHECK
__device__ __forceinline__ float bfv(const bf16* p, size_t i) { return bf_lo((unsigned)p[i]); }
__device__ __forceinline__ void chk_flag(unsigned* flags, int bit, float fast, float ref) { if (!(fabsf(fast - ref) <= 0.03f * fabsf(ref) + 0.03f)) atomicOr(flags, 1u << bit); }
__global__ void chk(Args a, int which) {
    unsigned char* ws = a.ws; unsigned* flags = (unsigned*)ws;
    const bf16* HN = (const bf16*)(ws + WS_HN); const bf16* MIX = (const bf16*)(ws + WS_MIX); const bf16* BIG = (const bf16*)(ws + WS_BIG);
    const bf16* VT = (const bf16*)(ws + WS_BIG + BIG_VT); const bf16* VT2 = (const bf16*)(ws + WS_BIG + BIG_VT2); const bf16* Yb = (const bf16*)(ws + WS_BIG + BIG_Y);
    const int i = threadIdx.x; const unsigned hsh = (unsigned)(i + 1) * 2654435761u;
    unsigned long long* slots = (unsigned long long*)(ws + 4096);
    if (which == 100) { if (i == 0) *flags = 0u; slots[i] = 0ull; return; }
    if (which == 101) { if (i == 0) { unsigned f = 0; for (int p = 0; p < 6; ++p) if (slots[2 * p] != slots[2 * p + 1]) f |= 1u << p; a.out[0] = 1000.f + 100.f * (float)f; } return; }
    if (which == 0) {
        const int row = hsh % NT, col = (hsh >> 7) % FF; float g = 0.f, u = 0.f;
        for (int k = 0; k < DM; ++k) { const float h = bfv(HN, (size_t)row * DM + k); g += h * a.in[2][(size_t)k * FF + col]; u += h * a.in[3][(size_t)k * FF + col]; }
        chk_flag(flags, 0, bfv(BIG, (size_t)row * FF + col), g / (1.f + expf(-g)) * u);
    } else if (which == 1) {
        const int row = hsh % NT, col = (i < 32) ? (hsh >> 7) % 3584 : 3584 + (hsh >> 7) % 1536; float p = 0.f;
        for (int k = 0; k < DM; ++k) p += bfv(HN, (size_t)row * DM + k) * a.in[5][(size_t)k * 5120 + col];
        chk_flag(flags, 1, col < 3584 ? bfv(BIG, (size_t)row * 3584 + col) : bfv(VT, (size_t)(col - 3584) * NT + row), p);
    } else if (which == 2) {
        const int tok = (i < 8) ? i * 4096 / 2 + i : hsh % NT, c = (hsh >> 9) % 512, g = c >> 7, d = c & 127, W = 2 << g, tpos = tok & 4095;
        const int nwin = tpos + 1 < W ? tpos + 1 : W; float y = 0.f;
        for (int cc = 0; cc < 128; ++cc) { float sm = 0.f; for (int q = 0; q < nwin; ++q) sm += bfv(BIG, (size_t)(tok - q) * 3584 + g * 128 + cc);
            y += (sm / nwin - bfv(BIG, (size_t)tok * 3584 + g * 128 + cc)) * a.in[6][((size_t)g * 128 + cc) * 128 + d]; }
        chk_flag(flags, 2, bfv(MIX, (size_t)tok * DM + c), y * a.in[7][c]);
    } else if (which == 3) {
        const int b = i & 3, h = (hsh >> 5) % 12, d = (hsh >> 11) & 127; const int t = (i < 16) ? i * 3 : (hsh >> 3) % 4096; const size_t tb = (size_t)b * 4096;
        float later = 0.f, acc = 0.f;
        for (int sidx = t - 1; sidx >= 0; --sidx) { float z = 0.f;
            for (int k = 0; k < 128; ++k) z += bfv(BIG, (tb + t) * 3584 + 512 + h * 128 + k) * bfv(BIG, (tb + sidx) * 3584 + 2048 + h * 128 + k);
            z *= 0.08838834764831845f;
            const float sp = log1pf(expf(-fabsf(z))); const float lsp = fminf(z, 0.f) - sp, lsn = -(fmaxf(z, 0.f) + sp);
            acc += expf(lsp + later) * bfv(VT, (size_t)(h * 128 + d) * NT + tb + sidx); later += lsn; if (later < -200.f) break; }
        chk_flag(flags, 3, bfv(MIX, (tb + t) * DM + 512 + h * 128 + d), acc);
        if (!(fabsf(bfv(MIX, (tb + t) * DM + 512 + h * 128 + d) - acc) <= 0.3f)) atomicOr(flags, 1u << 4);
    } else if (which == 4) {
        const int b = i & 3, g = (hsh >> 5) & 63, ch = (hsh >> 12) & 15; const int t = (i < 8) ? i * 9 : (i < 24 ? 60 + i * 7 : (hsh >> 3) % 1500); const size_t tb = (size_t)b * 4096;
        const float dt = expf(a.in[12][g]); float y = 0.f;
        for (int n = 0; n < 64; ++n) {
            const float are = a.in[10][g * 64 + n], aim = a.in[11][g * 64 + n]; const float mag = expf(are * dt); float sn, cs; sincos_f(aim * dt, sn, cs);
            const float lr = mag * cs, li = mag * sn, den = are * are + aim * aim, nr = lr - 1.f; const float fre = (nr * are + li * aim) / den, fim = (li * are - nr * aim) / den;
            float sr = 0.f, si = 0.f;
            for (int q = 0; q <= t; ++q) { float bur = 0.f, bui = 0.f;
                for (int c = 0; c < 16; ++c) { const float br = a.in[13][(size_t)(g * 64 + n) * 16 + c], bi = a.in[14][(size_t)(g * 64 + n) * 16 + c], u = bfv(BIG, (tb + q) * 2048 + g * 16 + c);
                    bur += (fre * br - fim * bi) * u; bui += (fre * bi + fim * br) * u; }
                const float nsr = lr * sr - li * si + bur; si = lr * si + li * sr + bui; sr = nsr; }
            y += a.in[15][(size_t)(g * 16 + ch) * 64 + n] * sr - a.in[16][(size_t)(g * 16 + ch) * 64 + n] * si; }
        y += a.in[17][g * 16 + ch] * bfv(BIG, (tb + t) * 2048 + g * 16 + ch);
        chk_flag(flags, 4, bfv(Yb, (tb + t) * 1024 + g * 16 + ch), pg8::gelu_f(y));
    } else if (which == 6) {
        const bf16* Fb = (const bf16*)(ws + WS_F); const int row = hsh % NT, col = (hsh >> 7) % DM; float f = 0.f;
        for (int k = 0; k < FF; ++k) f += bfv(BIG, (size_t)row * FF + k) * a.in[4][(size_t)k * DM + col];
        chk_flag(flags, 0, bfv(Fb, (size_t)row * DM + col), f);
    } else if (which == 7) {
        const bf16* Fb = (const bf16*)(ws + WS_F); const int row = 1 + hsh % (NT - 1), col = (hsh >> 7) % DM; float ss = 0.f, s2 = 0.f;
        for (int k = 0; k < DM; ++k) { const float f = bfv(Fb, (size_t)row * DM + k); ss += f * f; const float o = a.out[(size_t)row * DM + k]; s2 += o * o; }
        const float xn = a.in[0][(size_t)row * DM + col] + 0.5f * bfv(Fb, (size_t)row * DM + col) / sqrtf(ss / DM + EPS) * a.in[1][1 * DM + col];
        chk_flag(flags, 1, a.out[(size_t)row * DM + col], xn);
        chk_flag(flags, 1, bfv(HN, (size_t)row * DM + col), a.out[(size_t)row * DM + col] / sqrtf(s2 / DM + EPS) * a.in[1][2 * DM + col]);
    } else if (which == 8) {
        const bf16* Fb = (const bf16*)(ws + WS_F); const int row = hsh % NT, col = (hsh >> 7) % DM; float f = 0.f;
        for (int k = 0; k < DM; ++k) f += bfv(MIX, (size_t)row * DM + k) * a.in[8][(size_t)k * DM + col];
        chk_flag(flags, 2, bfv(Fb, (size_t)row * DM + col), f);
    } else if (which == 9) {
        const int row = hsh % NT, col = (hsh >> 7) % 1024; float f = a.in[19][col];
        for (int k = 0; k < 1024; ++k) f += bfv(Yb, (size_t)row * 1024 + k) * a.in[18][(size_t)k * 1024 + col];
        chk_flag(flags, 5, bfv(MIX, (size_t)row * DM + col), bfv(Yb, (size_t)row * 1024 + col) / (1.f + expf(-f)));
    } else if (which == 5) {
        const int tok = hsh % NT, h = (hsh >> 4) & 7, d = (hsh >> 9) & 127, t = tok & 127, tok0 = tok - t; float m = 0.f;
        for (int sidx = 0; sidx <= t; ++sidx) { float ss = 0.f; for (int c = 0; c < 1024; ++c) { const float v = bfv(VT2, (size_t)c * NT + tok0 + sidx); ss += v * v; }
            m += a.in[21][((size_t)h * 128 + t) * 128 + sidx] * bfv(VT2, (size_t)(h * 128 + d) * NT + tok0 + sidx) / sqrtf(ss / 1024.f + EPS); }
        const float o = bfv(BIG, (size_t)tok * 2048 + 1024 + h * 128 + d) * (a.in[20][h * 128 + d] * m + a.in[22][h * 128 + t]);
        chk_flag(flags, 5, bfv(MIX, (size_t)tok * DM + 1024 + h * 128 + d), o);
    }
}
#endif

#if MK_CHECK
__global__ void cks(const unsigned* buf, size_t nwords, unsigned long long* slot) {
    unsigned long long sum = 0; const size_t stride = (size_t)gridDim.x * blockDim.x;
    for (size_t i = (size_t)blockIdx.x * blockDim.x + threadIdx.x; i < nwords; i += stride) sum += (unsigned long long)buf[i] * (1 + (i & 1023));
    atomicAdd(slot, sum);
}
#endif
extern "C" void kernel_launch(void* const* d_in, const int* in_sizes, int n_in, void* d_out, int out_size, void* d_ws, size_t ws_size, hipStream_t stream) {
    static int grid = 0;
    if (grid == 0) {
        if (n_in != 24 || ws_size < WS_END) { fprintf(stderr, "kernel_launch: unexpected n_in %d or ws_size %zu (< %zu)\n", n_in, ws_size, (size_t)WS_END); grid = -1; return; }
        int dev = 0, cus = 0, per_cu = 0;
        (void)hipGetDevice(&dev); (void)hipDeviceGetAttribute(&cus, hipDeviceAttributeMultiprocessorCount, dev);
        if (hipFuncSetAttribute((const void*)fwd, hipFuncAttributeMaxDynamicSharedMemorySize, LDS_BYTES) != hipSuccess) { fprintf(stderr, "kernel_launch: hipFuncSetAttribute failed\n"); grid = -1; return; }
        if (hipOccupancyMaxActiveBlocksPerMultiprocessor(&per_cu, (const void*)fwd, 512, LDS_BYTES) != hipSuccess || per_cu < 1) per_cu = 1;
        (void)hipGetLastError();
        grid = cus * per_cu;
        if (grid <= 0) grid = 256;
    }
    if (grid < 0) return;
    Args a{};
    for (int i = 0; i < 24; ++i) a.in[i] = (const float*)d_in[i];
    a.out = (float*)d_out; a.ws = (unsigned char*)d_ws;
#if MK_MULTI
    for (int ph = 0; ph < MK_STOP; ++ph) {
        if (ph == 6 || ph == 7) continue;
        a.ph_lo = ph; a.ph_hi = ph + 1;
        hipLaunchKernelGGL(fwd, dim3(grid), dim3(512), LDS_BYTES, stream, a);
#if MK_CHECK
        {
            unsigned char* w8 = (unsigned char*)d_ws; unsigned long long* slots = (unsigned long long*)(w8 + 4096);
            if (ph == 0) hipLaunchKernelGGL(chk, dim3(1), dim3(64), 0, stream, a, 100);
            int pair = -1; const unsigned* buf = nullptr; size_t nw = 0;
            if (ph == 1) { pair = 0; buf = (const unsigned*)(w8 + WS_BIG); nw = (size_t)NT * FF / 2; }
            if (ph == 2) { pair = 1; buf = (const unsigned*)(w8 + WS_F); nw = (size_t)NT * DM / 2; }
            if (ph == 4) { pair = 2; buf = (const unsigned*)(w8 + WS_BIG); nw = (size_t)160 * MiB / 4; }
            if (ph == 5) { pair = 3; buf = (const unsigned*)(w8 + WS_MIX); nw = (size_t)NT * DM / 2; }
            if (ph == 8) { pair = 4; buf = (const unsigned*)(w8 + WS_F); nw = (size_t)NT * DM / 2; }
            if (ph == 3) { pair = 5; buf = (const unsigned*)(w8 + WS_HN); nw = (size_t)NT * DM / 2; }
            if (pair >= 0) {
                hipLaunchKernelGGL(cks, dim3(1024), dim3(256), 0, stream, buf, nw, slots + 2 * pair);
                if (ph != 3) hipLaunchKernelGGL(fwd, dim3(grid), dim3(512), LDS_BYTES, stream, a);
                hipLaunchKernelGGL(cks, dim3(1024), dim3(256), 0, stream, buf, nw, slots + 2 * pair + 1);
            }
            if (ph == N_PHASES - 1) hipLaunchKernelGGL(chk, dim3(1), dim3(64), 0, stream, a, 101);
        }
#endif
    }
#else
    a.ph_lo = 0; a.ph_hi = N_PHASES;
    (void)hipMemsetAsync(d_ws, 0, 65536, stream);
    void* args[] = {&a};
    hipError_t e = hipLaunchCooperativeKernel((const void*)fwd, dim3(grid), dim3(512), args, LDS_BYTES, stream);
    if (e != hipSuccess) fprintf(stderr, "kernel_launch: cooperative launch failed: %s (grid %d)\n", hipGetErrorString(e), grid);
#endif
}
```

```cpp
#include <hip/hip_runtime.h>
#include <hip/hip_cooperative_groups.h>
#include <cstdio>
#include <cstdint>
namespace cg = cooperative_groups;
namespace pg8 {
#define PG8_LAS __attribute__((address_space(3)))
typedef unsigned short bf16_t;
typedef short bf16x8 __attribute__((ext_vector_type(8)));
typedef float f32x4 __attribute__((ext_vector_type(4)));
typedef unsigned u32x4 __attribute__((ext_vector_type(4)));
constexpr int BM = 256, BK = 64, HALF = 128, HTB = HALF * BK * 2  , STAGE_BYTES = 8 * HTB, NXCD = 8, WGM = 8;

__host__ __device__ __forceinline__ int lds_byte(int r, int c) { const int st = (r >> 4) * 2 + (c >> 5), rr = r & 15, cc = c & 31, ob = rr * 64 + cc * 2; return st * 1024 + (ob ^ (((ob >> 9) & 1) << 5)); }
__host__ __device__ __forceinline__ void stage_rc(int b, int& R, int& C) { const int st = b / 1024, sb = b % 1024, swz = sb ^ (((sb >> 9) & 1) << 5); R = (st >> 1) * 16 + swz / 64; C = (st & 1) * 32 + (swz % 64) / 2; }
__host__ __device__ __forceinline__ int perm32(int rho) { const int n = rho >> 4, i = rho & 15; return 8 * (i >> 2) + 4 * n + (i & 3); }

struct Unit { int pm, pn; };
struct Gemm { const bf16_t* A; const bf16_t* Bt; int M, N, K; };

struct StaticOrder {
    int nM, nN, nwg, G, c;
    __host__ __device__ void init(int M, int N, int G_, int c_) { nM = M / BM; nN = N / BM; nwg = nM * nN; G = G_; c = c_; }
    __host__ __device__ bool next(int i, Unit& u) const {
        const long L = (long)i * G + c; if (L >= nwg) return false;
        int wgid = (int)L; { const int q = nwg / NXCD, r = nwg % NXCD, xcd = wgid % NXCD, off = wgid / NXCD; wgid = (xcd < r ? xcd * (q + 1) : r * (q + 1) + (xcd - r) * q) + off; }
        const int nig = WGM * nN, gid = wgid / nig, fm = gid * WGM, gsz = (nM - fm) < WGM ? (nM - fm) : WGM;
        u.pm = fm + ((wgid % nig) % gsz); u.pn = (wgid % nig) / gsz; return true;
    }
    __device__ __forceinline__ void a_ready(const Unit&) const {}
    __device__ __forceinline__ void done(const Unit&) const {}
};

__device__ __forceinline__ unsigned cvt_pk_bf16(float lo, float hi) { unsigned r; asm volatile("v_cvt_pk_bf16_f32 %0, %1, %2" : "=v"(r) : "v"(lo), "v"(hi)); return r; }
typedef float f32x2 __attribute__((ext_vector_type(2)));
__device__ __forceinline__ f32x2 gelu_pk(f32x2 v) {
    const f32x2 av = __builtin_elementwise_abs(v), d = av * 0.2316418882f + 1.0f;
    f32x2 t; t.x = __builtin_amdgcn_rcpf(d.x); t.y = __builtin_amdgcn_rcpf(d.y);
    f32x2 q = t * 0.5307027145f + (-0.7265760135f); q = q * t + 0.7107068705f; q = q * t + (-0.142248368f); q = q * t + 0.127414796f; q = q * t;
    const f32x2 s = (v * v) * (-0.72134752044f);
    f32x2 e; e.x = __builtin_amdgcn_exp2f(s.x); e.y = __builtin_amdgcn_exp2f(s.y);
    const f32x2 m = v * (q * e), r = v - m;
    f32x2 o; o.x = v.x < 0.f ? m.x : r.x; o.y = v.y < 0.f ? m.y : r.y; return o;
}

template <int ACT  > struct EpiBf16 {
    static constexpr bool PERM = true, AFTER_DRAIN = false; static_assert(ACT == 0 || ACT == 1, "EpiBf16: ACT is 0 (none) or 1 (gelu_pk)");
    bf16_t* O; int ldc; const float* bias; int split_cols; size_t split_stride; float scale0;
    __device__ __forceinline__ void operator()(const f32x4 (&acc)[2][2][4][2], const Unit& u, int wr, int wc, int fr, int fq) const {
        const int row0 = u.pm * BM + wr * 64 + fr; int colt = u.pn * BM; bf16_t* base = O;
        float sc = 1.f; if (split_cols) { const int t = colt / split_cols; base += (size_t)t * split_stride; colt -= t * split_cols; if (t == 0) sc = scale0; }
        const int col0 = colt + wc * 32 + 8 * fq, bcol0 = u.pn * BM + wc * 32 + 8 * fq;
        f32x4 bv[2][2];
#pragma unroll
        for (int bj = 0; bj < 2; ++bj)
#pragma unroll
            for (int n = 0; n < 2; ++n) bv[bj][n] = bias ? *(const f32x4*)(bias + bcol0 + bj * HALF + 4 * n) : (f32x4){0.f, 0.f, 0.f, 0.f};
#pragma unroll
        for (int ai = 0; ai < 2; ++ai)
#pragma unroll
            for (int m = 0; m < 4; ++m) { bf16_t* rowp = base + (size_t)(row0 + ai * HALF + m * 16) * ldc + col0;
#pragma unroll
                for (int bj = 0; bj < 2; ++bj) { f32x4 v0 = acc[ai][bj][m][0] + bv[bj][0], v1 = acc[ai][bj][m][1] + bv[bj][1];
                    if (ACT == 1) { f32x2 a = gelu_pk((f32x2){v0[0], v0[1]}), b = gelu_pk((f32x2){v0[2], v0[3]}), c = gelu_pk((f32x2){v1[0], v1[1]}), d = gelu_pk((f32x2){v1[2], v1[3]});
                        v0 = (f32x4){a.x, a.y, b.x, b.y}; v1 = (f32x4){c.x, c.y, d.x, d.y}; }
                    v0 = v0 * sc; v1 = v1 * sc; u32x4 w; w.x = cvt_pk_bf16(v0[0], v0[1]); w.y = cvt_pk_bf16(v0[2], v0[3]); w.z = cvt_pk_bf16(v1[0], v1[1]); w.w = cvt_pk_bf16(v1[2], v1[3]);
                    *(u32x4*)(rowp + bj * HALF) = w; } }
    }
};

__device__ __forceinline__ float sigm_f(float x) { return __builtin_amdgcn_rcpf(1.0f + __expf(-x)); }
__device__ __forceinline__ float silu_f(float x) { return x * sigm_f(x); }
__device__ __forceinline__ float gelu_f(float x) { return x * sigm_f(x * (1.5957691216f + 0.0713548163f * x * x)); }
__device__ __forceinline__ unsigned short f2bf_rne(float f) { unsigned u = __builtin_bit_cast(unsigned, f); return (unsigned short)((u + 0x7fffu + ((u >> 16) & 1u)) >> 16); }

__device__ __forceinline__ f32x2 silu_mul_pk(f32x2 g, f32x2 u) {
    const f32x2 e = g * (-1.4426950408889634f);
    f32x2 d; d.x = __builtin_amdgcn_exp2f(e.x); d.y = __builtin_amdgcn_exp2f(e.y);
    d = d + 1.0f;
    f32x2 r; r.x = __builtin_amdgcn_rcpf(d.x); r.y = __builtin_amdgcn_rcpf(d.y);
    return (g * u) * r;
}
struct EpiSwiglu {
    static constexpr bool PERM = true, AFTER_DRAIN = false;
    bf16_t* O; int ldc;
    __device__ __forceinline__ void operator()(const f32x4 (&acc)[2][2][4][2], const Unit& u, int wr, int wc, int fr, int fq) const {
        const int row0 = u.pm * BM + wr * 64 + fr, col0 = u.pn * HALF + wc * 32 + 8 * fq;
#pragma unroll
        for (int ai = 0; ai < 2; ++ai)
#pragma unroll
            for (int m = 0; m < 4; ++m) { bf16_t* rowp = O + (size_t)(row0 + ai * HALF + m * 16) * ldc + col0;
                const f32x4 g0 = acc[ai][0][m][0], g1 = acc[ai][0][m][1], u0 = acc[ai][1][m][0], u1 = acc[ai][1][m][1];
                const f32x2 a = silu_mul_pk((f32x2){g0[0], g0[1]}, (f32x2){u0[0], u0[1]}), b = silu_mul_pk((f32x2){g0[2], g0[3]}, (f32x2){u0[2], u0[3]});
                const f32x2 c = silu_mul_pk((f32x2){g1[0], g1[1]}, (f32x2){u1[0], u1[1]}), d = silu_mul_pk((f32x2){g1[2], g1[3]}, (f32x2){u1[2], u1[3]});
                u32x4 w; w.x = cvt_pk_bf16(a.x, a.y); w.y = cvt_pk_bf16(b.x, b.y); w.z = cvt_pk_bf16(c.x, c.y); w.w = cvt_pk_bf16(d.x, d.y);
                *(u32x4*)rowp = w; }
    }
};

struct EpiIn {
    static constexpr bool PERM = true, AFTER_DRAIN = false;
    bf16_t* O; int ldc; bf16_t* VT; int ldt; int split, gelu_from;
    __device__ __forceinline__ void operator()(const f32x4 (&acc)[2][2][4][2], const Unit& u, int wr, int wc, int fr, int fq) const {
        const int row0 = u.pm * BM + wr * 64 + fr, colt = u.pn * BM; const bool act = colt >= gelu_from;
        if (colt < split) {
            const int col0 = colt + wc * 32 + 8 * fq;
#pragma unroll
            for (int ai = 0; ai < 2; ++ai)
#pragma unroll
                for (int m = 0; m < 4; ++m) { bf16_t* rowp = O + (size_t)(row0 + ai * HALF + m * 16) * ldc + col0;
#pragma unroll
                    for (int bj = 0; bj < 2; ++bj) { f32x4 v0 = acc[ai][bj][m][0], v1 = acc[ai][bj][m][1];
                        if (act) {
#pragma unroll
                            for (int i = 0; i < 4; ++i) { v0[i] = gelu_f(v0[i]); v1[i] = gelu_f(v1[i]); } }
                        u32x4 w; w.x = cvt_pk_bf16(v0[0], v0[1]); w.y = cvt_pk_bf16(v0[2], v0[3]); w.z = cvt_pk_bf16(v1[0], v1[1]); w.w = cvt_pk_bf16(v1[2], v1[3]);
                        *(u32x4*)(rowp + bj * HALF) = w; } }
        } else {
            const int c0 = colt - split + wc * 32 + 8 * fq;
#pragma unroll
            for (int ai = 0; ai < 2; ++ai)
#pragma unroll
                for (int m = 0; m < 4; ++m) { const int row = row0 + ai * HALF + m * 16;
#pragma unroll
                    for (int bj = 0; bj < 2; ++bj)
#pragma unroll
                        for (int n = 0; n < 2; ++n) { f32x4 v = acc[ai][bj][m][n];
#pragma unroll
                            for (int i = 0; i < 4; ++i) { const float x = act ? gelu_f(v[i]) : v[i];
                                VT[(size_t)(c0 + bj * HALF + 4 * n + i) * ldt + row] = f2bf_rne(x); } } }
        }
    }
};

struct EpiGlu {
    static constexpr bool PERM = true, AFTER_DRAIN = false;
    const bf16_t* Y; int ldy; const float* bias; bf16_t* O; int ldc;
    __device__ __forceinline__ void operator()(const f32x4 (&acc)[2][2][4][2], const Unit& u, int wr, int wc, int fr, int fq) const {
        const int row0 = u.pm * BM + wr * 64 + fr, col0 = u.pn * BM + wc * 32 + 8 * fq;
#pragma unroll
        for (int ai = 0; ai < 2; ++ai)
#pragma unroll
            for (int m = 0; m < 4; ++m) { const int row = row0 + ai * HALF + m * 16;
#pragma unroll
                for (int bj = 0; bj < 2; ++bj) { const int col = col0 + bj * HALF;
                    const u32x4 yv = *(const u32x4*)(Y + (size_t)row * ldy + col);
                    const f32x4 b0 = *(const f32x4*)(bias + col), b1 = *(const f32x4*)(bias + col + 4);
                    const f32x4 v0 = acc[ai][bj][m][0] + b0, v1 = acc[ai][bj][m][1] + b1;
                    float y[8];
#pragma unroll
                    for (int i = 0; i < 4; ++i) { y[2 * i] = __builtin_bit_cast(float, yv[i] << 16); y[2 * i + 1] = __builtin_bit_cast(float, yv[i] & 0xffff0000u); }
                    u32x4 w; w.x = cvt_pk_bf16(y[0] * sigm_f(v0[0]), y[1] * sigm_f(v0[1])); w.y = cvt_pk_bf16(y[2] * sigm_f(v0[2]), y[3] * sigm_f(v0[3]));
                    w.z = cvt_pk_bf16(y[4] * sigm_f(v1[0]), y[5] * sigm_f(v1[1])); w.w = cvt_pk_bf16(y[6] * sigm_f(v1[2]), y[7] * sigm_f(v1[3]));
                    *(u32x4*)(O + (size_t)row * ldc + col) = w; } }
    }
};


template <class Epi, class Sched, bool ALIGN_EPI = false, bool SP2 = false>
__device__ __forceinline__ void gemm_phase(PG8_LAS unsigned char* lds, const Gemm g, const Sched& S, const Epi& E) {
    int tid_ = threadIdx.x; asm volatile("" : "+v"(tid_));
    const int tid = tid_, wid = __builtin_amdgcn_readfirstlane(tid >> 6), lane = tid & 63, wr = wid >> 2, wc = wid & 3, fr = lane & 15, fq = lane >> 4;
    const int K = g.K, nt = K / BK;
    unsigned voffA[2], voffB[2];
#pragma unroll
    for (int i = 0; i < 2; ++i) { int R, C; stage_rc(tid * 16 + i * 8192, R, C); const int Rb = Epi::PERM ? ((R & ~31) + perm32(R & 31)) : R;
        voffA[i] = (unsigned)(R * K + C) * 2u; voffB[i] = (unsigned)(Rb * K + C) * 2u; }
    const size_t kstep = (size_t)(BK * 2);
    const size_t hstep = (size_t)HALF * K * 2;
    const size_t tstep = 2 * hstep;
    const unsigned ldsw = (unsigned)wid * 1024u;
    const int aoff = lds_byte(wr * 64 + fr, fq * 8), boff = lds_byte(wc * 32 + fr, fq * 8);
#define PG8_SA(b, h) (((b) * 2 + (h)) * HTB)
#define PG8_SB(b, h) ((4 + (b) * 2 + (h)) * HTB)
#define PG8_STAGE(bufoff, gbase, voff) do { _Pragma("unroll") for (int _i = 0; _i < 2; ++_i) \
        __builtin_amdgcn_global_load_lds((const unsigned*)((const char*)(gbase) + (voff)[_i]), (PG8_LAS unsigned*)(lds + (bufoff) + ldsw + _i * 8192), 16, 0, 0); } while (0)
#define PG8_LDA(dst, b, h) do { _Pragma("unroll") for (int m = 0; m < 4; ++m) _Pragma("unroll") for (int k = 0; k < 2; ++k) dst[m][k] = *(const PG8_LAS bf16x8*)(lds + PG8_SA(b, h) + aoff + m * 2048 + k * 1024); } while (0)
#define PG8_LDB(dst, b, h) do { _Pragma("unroll") for (int n = 0; n < 2; ++n) _Pragma("unroll") for (int k = 0; k < 2; ++k) dst[n][k] = *(const PG8_LAS bf16x8*)(lds + PG8_SB(b, h) + boff + n * 2048 + k * 1024); } while (0)
#define PG8_MMA(ai, bj, At, Bt) do { __builtin_amdgcn_s_setprio(1); _Pragma("unroll") for (int m = 0; m < 4; ++m) _Pragma("unroll") for (int n = 0; n < 2; ++n) _Pragma("unroll") for (int k = 0; k < 2; ++k) \
        acc[ai][bj][m][n] = __builtin_amdgcn_mfma_f32_16x16x32_bf16(Bt[n][k], At[m][k], acc[ai][bj][m][n], 0, 0, 0); __builtin_amdgcn_s_setprio(0); } while (0)
#define PG8_WAIT_V(n) asm volatile("s_waitcnt vmcnt(" #n ")" ::: "memory")
#define PG8_WAIT_L(n) asm volatile("s_waitcnt lgkmcnt(" #n ")" ::: "memory")
#define PG8_BAR __builtin_amdgcn_s_barrier()
#define PG8_SCHED __builtin_amdgcn_sched_barrier(0)
    Unit cur, nxt; int ui = 0;
    if (!S.next(0, cur)) return;
    f32x4 acc[2][2][4][2];
#pragma unroll
    for (int a = 0; a < 2; ++a)
#pragma unroll
        for (int b = 0; b < 2; ++b)
#pragma unroll
            for (int m = 0; m < 4; ++m)
#pragma unroll
                for (int n = 0; n < 2; ++n) acc[a][b][m][n] = (f32x4){0.f, 0.f, 0.f, 0.f};
    bf16x8 At[4][2], B0[2][2], B1[2][2];
    const char* cA = (const char*)g.A + (size_t)cur.pm * tstep; const char* cB = (const char*)g.Bt + (size_t)cur.pn * tstep;
    S.a_ready(cur);
    if constexpr (SP2) {
        PG8_STAGE(PG8_SB(0, 0), cB, voffB); PG8_STAGE(PG8_SB(0, 1), cB + hstep, voffB); PG8_STAGE(PG8_SA(0, 0), cA, voffA); PG8_STAGE(PG8_SA(0, 1), cA + hstep, voffA);
        if (wr == 1) PG8_BAR;
        PG8_WAIT_V(2); PG8_BAR;
        PG8_STAGE(PG8_SB(1, 0), cB + kstep, voffB); PG8_STAGE(PG8_SA(1, 0), cA + kstep, voffA); PG8_STAGE(PG8_SB(1, 1), cB + hstep + kstep, voffB);
        PG8_WAIT_V(6); PG8_BAR;
    } else {
        PG8_STAGE(PG8_SB(0, 0), cB, voffB); PG8_STAGE(PG8_SA(0, 0), cA, voffA); PG8_STAGE(PG8_SB(0, 1), cB + hstep, voffB); PG8_STAGE(PG8_SA(0, 1), cA + hstep, voffA);
        if (wr == 1) PG8_BAR;
        PG8_WAIT_V(4); PG8_BAR;
        PG8_STAGE(PG8_SB(1, 0), cB + kstep, voffB); PG8_STAGE(PG8_SA(1, 0), cA + kstep, voffA); PG8_STAGE(PG8_SB(1, 1), cB + hstep + kstep, voffB);
        PG8_WAIT_V(6); PG8_BAR;
    }
    for (;;) {
        const bool has_next = S.next(ui + 1, nxt);
        const char* nA = has_next ? (const char*)g.A + (size_t)nxt.pm * tstep : cA; const char* nB = has_next ? (const char*)g.Bt + (size_t)nxt.pn * tstep : cB;
        for (int t = 0; t < nt; t += 2) {
            const bool last = (t == nt - 2);
            const char* a1 = cA + (size_t)(t + 1) * kstep;
            const char* a2 = last ? nA : cA + (size_t)(t + 2) * kstep; const char* b2 = last ? nB : cB + (size_t)(t + 2) * kstep;
            const char* a3 = a2 + kstep; const char* b3 = b2 + kstep;
            if (last && has_next) S.a_ready(nxt);
            if constexpr (SP2) {
            PG8_LDB(B0, 0, 0); PG8_LDB(B1, 0, 1); PG8_SCHED; PG8_LDA(At, 0, 0); PG8_STAGE(PG8_SA(1, 1), a1 + hstep, voffA);
            PG8_WAIT_V(8); PG8_WAIT_L(0); PG8_BAR; PG8_MMA(0, 0, At, B0); PG8_MMA(0, 1, At, B1); PG8_BAR; PG8_SCHED;
            PG8_LDA(At, 0, 1); PG8_STAGE(PG8_SB(0, 0), b2, voffB); PG8_STAGE(PG8_SB(0, 1), b2 + hstep, voffB); PG8_STAGE(PG8_SA(0, 0), a2, voffA);
            PG8_WAIT_V(8); PG8_WAIT_L(0); PG8_BAR; PG8_MMA(1, 0, At, B0); PG8_MMA(1, 1, At, B1); PG8_BAR; PG8_SCHED;
            PG8_LDB(B0, 1, 0); PG8_LDB(B1, 1, 1); PG8_SCHED; PG8_LDA(At, 1, 0); PG8_STAGE(PG8_SA(0, 1), a2 + hstep, voffA);
            PG8_WAIT_V(8); PG8_WAIT_L(0); PG8_BAR; PG8_MMA(0, 0, At, B0); PG8_MMA(0, 1, At, B1); PG8_BAR; PG8_SCHED;
            PG8_LDA(At, 1, 1); PG8_STAGE(PG8_SB(1, 0), b3, voffB); PG8_STAGE(PG8_SB(1, 1), b3 + hstep, voffB); PG8_STAGE(PG8_SA(1, 0), a3, voffA);
            PG8_WAIT_V(8); PG8_WAIT_L(0); PG8_BAR; PG8_MMA(1, 0, At, B0); PG8_MMA(1, 1, At, B1); PG8_BAR; PG8_SCHED;
            } else {
            PG8_LDB(B0, 0, 0); PG8_SCHED; PG8_LDA(At, 0, 0); PG8_STAGE(PG8_SA(1, 1), a1 + hstep, voffA);
            PG8_WAIT_L(8); PG8_BAR; PG8_WAIT_L(0); PG8_MMA(0, 0, At, B0); PG8_BAR; PG8_SCHED;
            PG8_LDB(B1, 0, 1); PG8_STAGE(PG8_SB(0, 0), b2, voffB);
            PG8_BAR; PG8_WAIT_L(0); PG8_MMA(0, 1, At, B1); PG8_BAR;
            PG8_LDA(At, 0, 1); PG8_STAGE(PG8_SA(0, 0), a2, voffA);
            PG8_BAR; PG8_WAIT_L(0); PG8_MMA(1, 0, At, B0); PG8_BAR; PG8_SCHED;
            PG8_STAGE(PG8_SB(0, 1), b2 + hstep, voffB);
            PG8_WAIT_V(6); PG8_BAR; PG8_MMA(1, 1, At, B1); PG8_BAR;
            PG8_LDB(B0, 1, 0); PG8_SCHED; PG8_LDA(At, 1, 0); PG8_STAGE(PG8_SA(0, 1), a2 + hstep, voffA);
            PG8_WAIT_L(8); PG8_BAR; PG8_WAIT_L(0); PG8_MMA(0, 0, At, B0); PG8_BAR; PG8_SCHED;
            PG8_LDB(B1, 1, 1); PG8_STAGE(PG8_SB(1, 0), b3, voffB);
            PG8_BAR; PG8_WAIT_L(0); PG8_MMA(0, 1, At, B1); PG8_BAR;
            PG8_LDA(At, 1, 1); PG8_STAGE(PG8_SA(1, 0), a3, voffA);
            PG8_BAR; PG8_WAIT_L(0); PG8_MMA(1, 0, At, B0); PG8_BAR; PG8_SCHED;
            PG8_STAGE(PG8_SB(1, 1), b3 + hstep, voffB);
            PG8_WAIT_V(6); PG8_BAR; PG8_MMA(1, 1, At, B1); PG8_BAR;
            }
        }
        if constexpr (ALIGN_EPI) { if (wr == 0) PG8_BAR; }
        if constexpr (!Epi::AFTER_DRAIN) { E(acc, cur, wr, wc, fr, fq); S.done(cur); }
        if (!has_next) break;
#pragma unroll
        for (int a = 0; a < 2; ++a)
#pragma unroll
            for (int b = 0; b < 2; ++b)
#pragma unroll
                for (int m = 0; m < 4; ++m)
#pragma unroll
                    for (int n = 0; n < 2; ++n) acc[a][b][m][n] = (f32x4){0.f, 0.f, 0.f, 0.f};
        cur = nxt; cA = nA; cB = nB; ++ui;
        if constexpr (ALIGN_EPI) { if (wr == 1) PG8_BAR; }
    }
    PG8_WAIT_V(0);
    if constexpr (!ALIGN_EPI) { if (wr == 0) PG8_BAR; }
    PG8_BAR;
    if constexpr (Epi::AFTER_DRAIN) { E.fused(acc, cur, wr, wc, fr, fq, lds, wid, lane); S.done(cur); }
#undef PG8_SA
#undef PG8_SB
#undef PG8_STAGE
#undef PG8_LDA
#undef PG8_LDB
#undef PG8_MMA
#undef PG8_WAIT_V
#undef PG8_WAIT_L
#undef PG8_BAR
#undef PG8_SCHED
}
}

#ifndef MK_ALIGN
#define MK_ALIGN true
#endif
#ifndef MK_SP2
#define MK_SP2 true
#endif
#ifndef MK_STOP
#define MK_STOP N_PHASES
#endif
#ifndef MK_CHECK
#define MK_CHECK 0
#endif
#ifndef MK_DUPMASK
#define MK_DUPMASK 0
#endif
#ifndef MK_XSYNC
#define MK_XSYNC 0
#endif
#ifndef MK_TPH
#define MK_TPH -1
#endif
#ifndef MK_XBF16
#define MK_XBF16 1
#endif
#ifndef MK_TPH_END
#define MK_TPH_END 0
#endif
#ifndef MK_MULTI
#define MK_MULTI 0
#endif
#define LAS __attribute__((address_space(3)))
typedef unsigned short bf16;
using pg8::f32x4; using pg8::bf16x8; using pg8::u32x4;
typedef unsigned u32x2 __attribute__((ext_vector_type(2)));

constexpr int NT = 16384, DM = 2048, FF = 5632, SEQ = 4096;
constexpr float EPS = 1e-6f;
constexpr size_t MiB = 1u << 20;
constexpr size_t WS_WGU = 2 * MiB, WS_WD = 178 * MiB, WS_WEIN = 266 * MiB, WS_WEOUT = 286 * MiB, WS_WOIN = 294 * MiB, WS_WOOUT = 306 * MiB,
                 WS_WGLU = 314 * MiB, WS_PWT = 316 * MiB, WS_HN = 318 * MiB, WS_MIX = 382 * MiB, WS_F = 446 * MiB, WS_BIG = 510 * MiB, WS_XB = 686 * MiB, WS_END = 750 * MiB;
constexpr size_t BIG_VT = 112 * MiB;
constexpr size_t BIG_VT2 = 64 * MiB, BIG_Y = 96 * MiB, BIG_E = 128 * MiB, BIG_RSTD = 136 * MiB;
constexpr int LDS_BYTES = 147456;
constexpr int N_PHASES = 25;
constexpr int CW_BAR = 4096;

struct Args { const float* in[24]; float* out; unsigned char* ws; int ph_lo, ph_hi;
#if MK_DUPMASK
  int dup_done, pad_;
#endif
};

__device__ __forceinline__ float bf_lo(unsigned x) { return __builtin_bit_cast(float, x << 16); }
__device__ __forceinline__ float bf_hi(unsigned x) { return __builtin_bit_cast(float, x & 0xffff0000u); }
typedef float f32x2_t __attribute__((ext_vector_type(2)));
typedef __bf16 bf16x2_t __attribute__((ext_vector_type(2)));
__device__ __forceinline__ unsigned pk2(float lo, float hi) { const f32x2_t v = {lo, hi}; const bf16x2_t b = __builtin_convertvector(v, bf16x2_t); return __builtin_bit_cast(unsigned, b); }
__device__ __forceinline__ float wave_sum(float v) {
#pragma unroll
    for (int o = 1; o < 64; o <<= 1) v += __shfl_xor(v, o);
    return v;
}
__device__ __forceinline__ f32x4 mfma16(bf16x8 a, bf16x8 b, f32x4 c) { return __builtin_amdgcn_mfma_f32_16x16x32_bf16(a, b, c, 0, 0, 0); }

#define XB_TMO      128
#define XB_XCNT(j)  (256  + 64 * (j))
#define XB_XSUB(j)  (1280 + 64 * (j))
#define XB_XGEN(j)  (2304 + 64 * (j))
#define XB_TOP      3328
#define XB_TOPGEN   3392
#define XCD_BAR_WORDS 3456
#define XB_SPIN_CAP (1u << 18)

__device__ __forceinline__ unsigned xb_ld(unsigned* p)              { return __hip_atomic_load(p, __ATOMIC_RELAXED, __HIP_MEMORY_SCOPE_AGENT); }
__device__ __forceinline__ unsigned xb_add(unsigned* p, unsigned v) { return __hip_atomic_fetch_add(p, v, __ATOMIC_RELAXED, __HIP_MEMORY_SCOPE_AGENT); }
__device__ __forceinline__ unsigned xb_xcc_id() { return (unsigned)__builtin_amdgcn_s_getreg((3 << 11) | 20) & 0xFu; }
#define XB_SPIN(cond, bar) do { unsigned _sp = 0; while (cond) { __builtin_amdgcn_s_sleep(1); \
    if ((++_sp & 255u) == 0u) { if (xb_ld(&(bar)[XB_TMO])) break; if (_sp > XB_SPIN_CAP) { atomicAdd(&(bar)[XB_TMO], 1u); break; } } } } while (0)

struct XcdBarrier {
    unsigned* bar; unsigned x;
    volatile LAS unsigned* st;
};

__device__ __forceinline__ XcdBarrier xcd_barrier_post(unsigned* bar, volatile LAS unsigned* st) {
    XcdBarrier b; b.bar = bar; b.x = xb_xcc_id(); b.st = st;
    if (threadIdx.x == 0) (void)xb_add(&bar[XB_XCNT(b.x)], 1u);
    return b;
}
__device__ __forceinline__ void xcd_barrier_complete(unsigned* bar, unsigned x, unsigned& nloc, unsigned& nx) {
    const unsigned G = gridDim.x * gridDim.y * gridDim.z;
    unsigned sum, cnt, mine, sp = 0u;
    for (;;) {
        sum = 0u; cnt = 0u; mine = 0u;
#pragma unroll
        for (unsigned j = 0; j < 16; ++j) { const unsigned c = xb_ld(&bar[XB_XCNT(j)]); sum += c; cnt += (c > 0u) ? 1u : 0u; mine = (j == x) ? c : mine; }
        if (sum == G) break;
        __builtin_amdgcn_s_sleep(1);
        if ((++sp & 255u) == 0u) { if (xb_ld(&bar[XB_TMO])) break; if (sp > XB_SPIN_CAP) { atomicAdd(&bar[XB_TMO], 1u); break; } }
    }
    nloc = mine > 0u ? mine : 1u; nx = cnt > 0u ? cnt : 1u;
}

__device__ __forceinline__ void xcd_barrier(const XcdBarrier& b) {
    asm volatile("s_waitcnt vmcnt(0)" ::: "memory");
    __syncthreads();
    if (threadIdx.x == 0) {
        unsigned* bar = b.bar;
        __builtin_amdgcn_s_waitcnt(0);
        unsigned nloc = b.st[0], nx = b.st[1];
        if (nloc == 0u) { xcd_barrier_complete(bar, b.x, nloc, nx); b.st[0] = nloc; b.st[1] = nx; }
        const unsigned old = xb_add(&bar[XB_XSUB(b.x)], 1u);
        const unsigned gen = old / nloc;
        if (old + 1u == (gen + 1u) * nloc) {
            __builtin_amdgcn_fence(__ATOMIC_RELEASE, "agent");
            asm volatile("s_waitcnt vmcnt(0)" ::: "memory");
            const unsigned og = xb_add(&bar[XB_TOP], 1u);
            const unsigned tg = og / nx;
            if (og + 1u == (tg + 1u) * nx) xb_add(&bar[XB_TOPGEN], 1u);
            else XB_SPIN(xb_ld(&bar[XB_TOPGEN]) == tg, bar);
            __builtin_amdgcn_fence(__ATOMIC_ACQUIRE, "agent");
            xb_add(&bar[XB_XGEN(b.x)], 1u);
            asm volatile("s_waitcnt vmcnt(0)" ::: "memory");
        } else {
            XB_SPIN(xb_ld(&bar[XB_XGEN(b.x)]) == gen, bar);
            __builtin_amdgcn_fence(__ATOMIC_ACQUIRE, "agent");
            asm volatile("s_waitcnt vmcnt(0)" ::: "memory");
        }
    }
    __syncthreads();
}

__device__ __forceinline__ void transpose_item(const float* W, int K, int N, bf16* WT, int item, LAS float* scr, int lane, int mode) {
    const int nblk = N / 32, kb = item / nblk, nb = item % nblk, k0 = 64 * kb, n0 = 32 * nb;
    int d0 = n0; if (mode) d0 = (n0 >> 7) * 256 + (n0 & 127) + (mode == 2 ? 128 : 0);
    { f32x4 v[8];
#pragma unroll
      for (int i = 0; i < 8; ++i) v[i] = __builtin_nontemporal_load((const f32x4*)(W + (size_t)(k0 + 8 * i + (lane >> 3)) * N + n0 + 4 * (lane & 7)));
#pragma unroll
      for (int i = 0; i < 8; ++i) { LAS float* d = scr + (8 * i + (lane >> 3)) * 33 + 4 * (lane & 7); d[0] = v[i][0]; d[1] = v[i][1]; d[2] = v[i][2]; d[3] = v[i][3]; } }
    asm volatile("s_waitcnt lgkmcnt(0)" ::: "memory");
    const int c = lane & 7;
#pragma unroll
    for (int j = 0; j < 4; ++j) { const int n = (lane >> 3) + 8 * j; const LAS float* s = scr + (8 * c) * 33 + n;
        u32x4 o; o.x = pk2(s[0 * 33], s[1 * 33]); o.y = pk2(s[2 * 33], s[3 * 33]); o.z = pk2(s[4 * 33], s[5 * 33]); o.w = pk2(s[6 * 33], s[7 * 33]);
        *(u32x4*)(WT + (size_t)(d0 + n) * K + k0 + 8 * c) = o; }
    asm volatile("s_waitcnt lgkmcnt(0)" ::: "memory");
}

__device__ __forceinline__ void phase_conv(const Args& a, LAS unsigned char* lds, int gw, int NGW, int wave, int lane) {
    LAS float* scr = (LAS float*)(lds + wave * 16384);
    unsigned char* ws = a.ws;
    constexpr int I_G = 32 * 176, I_D = 88 * 64, I_EIN = 32 * 160, I_SQ = 32 * 64, I_OIN = 32 * 96, I_GLU = 16 * 32, I_P = 2 * 4;
    constexpr int NITEMS = 8 * I_G + 4 * I_D + I_EIN + 2 * I_SQ + I_OIN + I_GLU + 4 * I_P;
    for (int it = gw; it < NITEMS; it += NGW) {
        int r = it;
        if (r < 8 * I_G) { const int m = r / I_G; r -= m * I_G; const int lf = m >> 1, up = m & 1;
            transpose_item((up ? a.in[3] : a.in[2]) + (size_t)lf * DM * FF, DM, FF, (bf16*)(ws + WS_WGU) + (size_t)lf * 11264 * 2048, r, scr, lane, 1 + up); continue; }
        r -= 8 * I_G;
        if (r < 4 * I_D) { const int lf = r / I_D; r -= lf * I_D;
            transpose_item(a.in[4] + (size_t)lf * FF * DM, FF, DM, (bf16*)(ws + WS_WD) + (size_t)lf * 2048 * 5632, r, scr, lane, 0); continue; }
        r -= 4 * I_D;
        if (r < I_EIN) { transpose_item(a.in[5], DM, 5120, (bf16*)(ws + WS_WEIN), r, scr, lane, 0); continue; } r -= I_EIN;
        if (r < I_SQ) { transpose_item(a.in[8], DM, DM, (bf16*)(ws + WS_WEOUT), r, scr, lane, 0); continue; } r -= I_SQ;
        if (r < I_SQ) { transpose_item(a.in[23], DM, DM, (bf16*)(ws + WS_WOOUT), r, scr, lane, 0); continue; } r -= I_SQ;
        if (r < I_OIN) { transpose_item(a.in[9], DM, 3072, (bf16*)(ws + WS_WOIN), r, scr, lane, 0); continue; } r -= I_OIN;
        if (r < I_GLU) { transpose_item(a.in[18], 1024, 1024, (bf16*)(ws + WS_WGLU), r, scr, lane, 0); continue; } r -= I_GLU;
        { const int g = r / I_P; r -= g * I_P; transpose_item(a.in[6] + (size_t)g * 128 * 128, 128, 128, (bf16*)(ws + WS_PWT) + (size_t)g * 128 * 128, r, scr, lane, 0); }
    }
}

__device__ __forceinline__ void unpack8(const u32x4 p, f32x4& lo, f32x4& hi) { lo = (f32x4){bf_lo(p.x), bf_hi(p.x), bf_lo(p.y), bf_hi(p.y)}; hi = (f32x4){bf_lo(p.z), bf_hi(p.z), bf_lo(p.w), bf_hi(p.w)}; }
__device__ __forceinline__ u32x4 pack8(const f32x4 lo, const f32x4 hi) { return (u32x4){pk2(lo[0], lo[1]), pk2(lo[2], lo[3]), pk2(hi[0], hi[1]), pk2(hi[2], hi[3])}; }
__device__ __forceinline__ void phase_row(const float* xsrc, const bf16* xsrc_b, const bf16* Fb, const float* gF, float alpha, float* xdst, bf16* xdst_b, const float* gH, bf16* HN, int gw, int NGW, int lane, unsigned npert) {
    f32x4 gFv[8], gHv[8];
#pragma unroll
    for (int j = 0; j < 4; ++j) { gFv[2 * j] = gF ? ((const f32x4*)gF)[128 * j + 2 * lane] : (f32x4){0.f, 0.f, 0.f, 0.f}; gFv[2 * j + 1] = gF ? ((const f32x4*)gF)[128 * j + 2 * lane + 1] : (f32x4){0.f, 0.f, 0.f, 0.f};
        gHv[2 * j] = gH ? ((const f32x4*)gH)[128 * j + 2 * lane] : (f32x4){0.f, 0.f, 0.f, 0.f}; gHv[2 * j + 1] = gH ? ((const f32x4*)gH)[128 * j + 2 * lane + 1] : (f32x4){0.f, 0.f, 0.f, 0.f}; }
    for (int m = gw; m < NT; m += NGW) {
        f32x4 v[8];
        if (xsrc_b) { const u32x4* xr = (const u32x4*)(xsrc_b + (size_t)m * DM) + lane;
#pragma unroll
            for (int j = 0; j < 4; ++j) unpack8(xr[64 * j], v[2 * j], v[2 * j + 1]); }
        else { const f32x4* xr = (const f32x4*)(xsrc + (size_t)m * DM) + 2 * lane;
#pragma unroll
            for (int j = 0; j < 4; ++j) { v[2 * j] = xr[128 * j]; v[2 * j + 1] = xr[128 * j + 1]; } }
        if (Fb) {
            const u32x4* fp = (const u32x4*)(Fb + (size_t)m * DM) + lane;
            f32x4 f[8]; float s = 0.f;
#pragma unroll
            for (int j = 0; j < 4; ++j) unpack8(fp[64 * j], f[2 * j], f[2 * j + 1]);
#pragma unroll
            for (int j = 0; j < 8; ++j) s += (f[j][0] * f[j][0] + f[j][1] * f[j][1]) + (f[j][2] * f[j][2] + f[j][3] * f[j][3]);
            const float rs = alpha / sqrtf(wave_sum(s) * (1.f / DM) + EPS);
#pragma unroll
            for (int j = 0; j < 8; ++j) v[j] = v[j] + f[j] * gFv[j] * rs;
#if MK_TPH != -1
            if (!gH) {
#pragma unroll
                for (int j = 0; j < 8; ++j)
#pragma unroll
                    for (int i = 0; i < 4; ++i) if ((unsigned)(m * DM + (64 * (j >> 1) + lane) * 8 + (j & 1) * 4 + i) < npert) v[j][i] += 0.05f; }
#endif
            if (xdst_b) { u32x4* xo = (u32x4*)(xdst_b + (size_t)m * DM) + lane;
#pragma unroll
                for (int j = 0; j < 4; ++j) __builtin_nontemporal_store(pack8(v[2 * j], v[2 * j + 1]), &xo[64 * j]); }
            else { f32x4* xo = (f32x4*)(xdst + (size_t)m * DM) + 2 * lane;
#pragma unroll
                for (int j = 0; j < 4; ++j) { __builtin_nontemporal_store(v[2 * j], &xo[128 * j]); __builtin_nontemporal_store(v[2 * j + 1], &xo[128 * j + 1]); } }
        }
        if (gH) {
            float s = 0.f;
#pragma unroll
            for (int j = 0; j < 8; ++j) s += (v[j][0] * v[j][0] + v[j][1] * v[j][1]) + (v[j][2] * v[j][2] + v[j][3] * v[j][3]);
            const float rs = 1.f / sqrtf(wave_sum(s) * (1.f / DM) + EPS);
            u32x4* ho = (u32x4*)(HN + (size_t)m * DM) + lane;
#pragma unroll
            for (int j = 0; j < 4; ++j) __builtin_nontemporal_store(pack8(v[2 * j] * gHv[2 * j] * rs, v[2 * j + 1] * gHv[2 * j + 1] * rs), &ho[64 * j]);
        }
    }
}

__device__ __forceinline__ void pool_item(const Args& a, const bf16* P, const bf16* PWT, bf16* MIX, int item, int wave, int lane) {
    const int fr = lane & 15, fq = lane >> 4;
    const int g = item & 3, tt = item >> 2;
    const int tok = tt * 128 + wave * 16 + fr, tpos = tok & (SEQ - 1), Wn = 2 << g;
    const int nwin = (tpos + 1 < Wn) ? tpos + 1 : Wn;
    const float inv = 1.0f / (float)nwin;
    bf16x8 af[4];
#pragma unroll
    for (int kk = 0; kk < 4; ++kk) {
        const bf16* p = P + (size_t)tok * 3584 + g * 128 + kk * 32 + fq * 8;
        float s[8];
#pragma unroll
        for (int e = 0; e < 8; ++e) s[e] = 0.f;
        const u32x4 own = *(const u32x4*)p;
        u32x4 rr[15];
#pragma unroll
        for (int d = 1; d < 16; ++d) if (d < Wn) { const int dd = (d <= tpos) ? d : 0; rr[d - 1] = *(const u32x4*)(p - (size_t)dd * 3584); }
#pragma unroll
        for (int e = 0; e < 4; ++e) { s[2 * e] = bf_lo(own[e]); s[2 * e + 1] = bf_hi(own[e]); }
#pragma unroll
        for (int d = 1; d < 16; ++d) if (d < Wn) { const float m = (d <= tpos) ? 1.f : 0.f;
#pragma unroll
            for (int e = 0; e < 4; ++e) { s[2 * e] += m * bf_lo(rr[d - 1][e]); s[2 * e + 1] += m * bf_hi(rr[d - 1][e]); } }
        u32x4 o;
#pragma unroll
        for (int e = 0; e < 4; ++e) o[e] = pk2(s[2 * e] * inv - bf_lo(own[e]), s[2 * e + 1] * inv - bf_hi(own[e]));
        af[kk] = __builtin_bit_cast(bf16x8, o);
    }
    const float* scale = a.in[7];
#pragma unroll
    for (int nt = 0; nt < 8; ++nt) {
        f32x4 acc = (f32x4){0.f, 0.f, 0.f, 0.f};
#pragma unroll
        for (int kk = 0; kk < 4; ++kk) { const bf16x8 wf = *(const bf16x8*)(PWT + ((size_t)(g * 128 + nt * 16 + fr)) * 128 + kk * 32 + fq * 8); acc = mfma16(wf, af[kk], acc); }
        const int c = g * 128 + nt * 16 + 4 * fq; const f32x4 sc = *(const f32x4*)(scale + c);
        *(u32x2*)(MIX + (size_t)tok * DM + c) = (u32x2){pk2(acc[0] * sc[0], acc[1] * sc[1]), pk2(acc[2] * sc[2], acc[3] * sc[3])};
    }
}

constexpr int AK_PITCH = 272, AV_PITCH = 80, AK_BYTES = 32 * AK_PITCH, AV_BYTES = 128 * AV_PITCH, ABUF = AK_BYTES + AV_BYTES, AFLAG_OFF = 2 * ABUF;
__device__ __forceinline__ void attn_wg_item(const bf16* P, const bf16* VT, bf16* MIX, LAS unsigned char* lds, int item, int wave, int lane, int tid) {
    const int fr = lane & 15, fq = lane >> 4;
    const int qblk = item & 31, bh = item >> 5, h = bh % 12, b = bh / 12;
    const int q0b = qblk * 128, q0 = q0b + wave * 16, t = q0 + fr; const size_t tokb = (size_t)b * SEQ;
    bf16x8 qf[4];
#pragma unroll
    for (int kk = 0; kk < 4; ++kk) qf[kk] = *(const bf16x8*)(P + (tokb + t) * 3584 + 512 + h * 128 + kk * 32 + fq * 8);
    f32x4 o[8];
#pragma unroll
    for (int dt = 0; dt < 8; ++dt) o[dt] = (f32x4){0.f, 0.f, 0.f, 0.f};
    float R = 0.f; bool done = false;
    const int krow = tid >> 4, kch = tid & 15, vrow = tid >> 2, vch = tid & 3;
    const bf16* kg = P + (tokb + krow) * 3584 + 2048 + h * 128 + kch * 8;
    const bf16* vg = VT + (size_t)(h * 128 + vrow) * NT + tokb + vch * 8;
    int kt = (q0b + 127) >> 5;
    u32x4 kr = *(const u32x4*)(kg + (size_t)(kt * 32) * 3584), vr = *(const u32x4*)(vg + kt * 32);
    for (;;) {
        LAS unsigned char* buf = lds + (kt & 1) * ABUF;
        volatile LAS unsigned* flg = (volatile LAS unsigned*)(lds + AFLAG_OFF + (kt & 1) * 64);
        *(LAS u32x4*)(buf + krow * AK_PITCH + kch * 16) = kr;
        *(LAS u32x4*)(buf + AK_BYTES + vrow * AV_PITCH + vch * 16) = vr;
        if (lane == 0) flg[wave] = done ? 1u : 0u;
        if (kt > 0) { kr = *(const u32x4*)(kg + (size_t)((kt - 1) * 32) * 3584); vr = *(const u32x4*)(vg + (kt - 1) * 32); }
        __syncthreads();
        unsigned alld = 1u;
#pragma unroll
        for (int w = 0; w < 8; ++w) alld &= flg[w];
        if (alld) break;
        const int s0 = kt * 32;
        if (!done && s0 <= q0 + 14) {
            f32x4 z[2]; z[0] = (f32x4){0.f, 0.f, 0.f, 0.f}; z[1] = z[0];
#pragma unroll
            for (int kk = 0; kk < 4; ++kk) { const bf16x8 k0 = *(const LAS bf16x8*)(buf + fr * AK_PITCH + kk * 64 + fq * 16), k1 = *(const LAS bf16x8*)(buf + (16 + fr) * AK_PITCH + kk * 64 + fq * 16);
                z[0] = mfma16(k0, qf[kk], z[0]); z[1] = mfma16(k1, qf[kk], z[1]); }
            float lsp[2][4], lk[2][4], tot[2];
#pragma unroll
            for (int sub = 0; sub < 2; ++sub) { tot[sub] = 0.f;
#pragma unroll
                for (int r = 0; r < 4; ++r) { const int key = s0 + sub * 16 + 4 * fq + r; const bool valid = key < t;
                    const float zz = z[sub][r] * 0.08838834764831845f;
                    const float l1p = 0.6931471805599453f * __builtin_amdgcn_logf(1.0f + __expf(-fabsf(zz)));
                    lsp[sub][r] = valid ? (fminf(zz, 0.f) - l1p) : -1e30f;
                    lk[sub][r] = valid ? -(fmaxf(zz, 0.f) + l1p) : 0.f;
                    tot[sub] += lk[sub][r]; } }
            float G[2], TT[2];
#pragma unroll
            for (int sub = 0; sub < 2; ++sub) {
                const float a1 = __shfl_down(tot[sub], 16), a2 = __shfl_down(tot[sub], 32), a3 = __shfl_down(tot[sub], 48);
                G[sub] = (fq < 3 ? a1 : 0.f) + (fq < 2 ? a2 : 0.f) + (fq < 1 ? a3 : 0.f);
                const float t1 = tot[sub] + __shfl_xor(tot[sub], 16); TT[sub] = t1 + __shfl_xor(t1, 32);
            }
            float w[2][4];
#pragma unroll
            for (int sub = 0; sub < 2; ++sub) { float later = R + G[sub] + (sub == 0 ? TT[1] : 0.f);
#pragma unroll
                for (int r = 3; r >= 0; --r) { w[sub][r] = __expf(lsp[sub][r] + later); later += lk[sub][r]; } }
            u32x4 wp; wp.x = pk2(w[0][0], w[0][1]); wp.y = pk2(w[0][2], w[0][3]); wp.z = pk2(w[1][0], w[1][1]); wp.w = pk2(w[1][2], w[1][3]);
            const bf16x8 wf = __builtin_bit_cast(bf16x8, wp);
            const LAS unsigned char* vb = buf + AK_BYTES + fr * AV_PITCH + fq * 8;
#pragma unroll
            for (int dt = 0; dt < 8; ++dt) { const u32x2 v0 = *(const LAS u32x2*)(vb + dt * 16 * AV_PITCH), v1 = *(const LAS u32x2*)(vb + dt * 16 * AV_PITCH + 32);
                const u32x4 vv = (u32x4){v0.x, v0.y, v1.x, v1.y};
                o[dt] = mfma16(__builtin_bit_cast(bf16x8, vv), wf, o[dt]); }
            R += TT[0] + TT[1];
            if (__all(R < -110.f)) done = true;
        }
        if (kt == 0) break;
        --kt;
    }
    __syncthreads();
    bf16* op = MIX + (tokb + t) * DM + 512 + h * 128 + 4 * fq;
#pragma unroll
    for (int dt = 0; dt < 8; ++dt) *(u32x2*)(op + dt * 16) = (u32x2){pk2(o[dt][0], o[dt][1]), pk2(o[dt][2], o[dt][3])};
}

__device__ __forceinline__ void sincos_f(float x, float& s, float& c) {
    const float k = rintf(x * 0.6366197723675814f);
    float r = fmaf(-k, 1.5707962513e+00f, x); r = fmaf(-k, 7.5497894159e-08f, r);
    const float r2 = r * r;
    const float sp = r + r * r2 * (-1.6666654611e-1f + r2 * (8.3321608736e-3f + r2 * (-1.9515295891e-4f)));
    const float cp = 1.0f - 0.5f * r2 + r2 * r2 * (4.166664568298827e-2f + r2 * (-1.388731625493765e-3f + r2 * 2.443315711809948e-5f));
    const int q = ((int)k) & 3;
    s = (q == 0) ? sp : (q == 1) ? cp : (q == 2) ? -sp : -cp;
    c = (q == 0) ? cp : (q == 1) ? -sp : (q == 2) ? -cp : sp;
}

typedef float f2v __attribute__((ext_vector_type(2)));
constexpr int SSM_ROWB = 272, SSM_TILEB = 64 * SSM_ROWB;
struct SsmOps { bf16x8 af[8]; bf16x8 cf[4]; f32x4 dsk; float lr, li, pr, pi; };
template <bool OUT>
__device__ __forceinline__ SsmOps ssm_setup(const Args& a, LAS unsigned char* lds, int wave, int g, int lane) {
    SsmOps o;
    const int n = lane, fr = lane & 15, fq = lane >> 4;
    const float dt = expf(a.in[12][g]);
    const float are = a.in[10][g * 64 + n], aim = a.in[11][g * 64 + n];
    const float mag = expf(are * dt); float sn, cs; sincos_f(aim * dt, sn, cs);
    const float lr = mag * cs, li = mag * sn;
    const float den = are * are + aim * aim, nr = lr - 1.0f;
    const float fre = (nr * are + li * aim) / den, fim = (li * are - nr * aim) / den;
    f2v bb[16];
    { const f32x4* br = (const f32x4*)(a.in[13] + (size_t)(g * 64 + n) * 16); const f32x4* bi = (const f32x4*)(a.in[14] + (size_t)(g * 64 + n) * 16);
#pragma unroll
      for (int q = 0; q < 4; ++q) { const f32x4 x = br[q], y = bi[q];
#pragma unroll
          for (int i = 0; i < 4; ++i) bb[4 * q + i] = (f2v){fre * x[i] - fim * y[i], fre * y[i] + fim * x[i]}; } }
    LAS unsigned char* tile = lds + wave * SSM_TILEB;
    { u32x4 w;
      w = (u32x4){pk2(bb[0].x, bb[1].x), pk2(bb[2].x, bb[3].x), pk2(bb[4].x, bb[5].x), pk2(bb[6].x, bb[7].x)};         *(LAS u32x4*)(tile + (2 * n) * 32) = w;
      w = (u32x4){pk2(bb[8].x, bb[9].x), pk2(bb[10].x, bb[11].x), pk2(bb[12].x, bb[13].x), pk2(bb[14].x, bb[15].x)};   *(LAS u32x4*)(tile + (2 * n) * 32 + 16) = w;
      w = (u32x4){pk2(bb[0].y, bb[1].y), pk2(bb[2].y, bb[3].y), pk2(bb[4].y, bb[5].y), pk2(bb[6].y, bb[7].y)};         *(LAS u32x4*)(tile + (2 * n + 1) * 32) = w;
      w = (u32x4){pk2(bb[8].y, bb[9].y), pk2(bb[10].y, bb[11].y), pk2(bb[12].y, bb[13].y), pk2(bb[14].y, bb[15].y)};   *(LAS u32x4*)(tile + (2 * n + 1) * 32 + 16) = w; }
    const bf16x8 zero8 = (bf16x8){0, 0, 0, 0, 0, 0, 0, 0};
#pragma unroll
    for (int nt = 0; nt < 8; ++nt) o.af[nt] = (fq < 2) ? *(const LAS bf16x8*)(tile + (nt * 16 + fr) * 32 + fq * 16) : zero8;
    asm volatile("s_waitcnt lgkmcnt(0)" ::: "memory");
    float pr = lr, pi = li;
#pragma unroll
    for (int q = 0; q < 6; ++q) { const float tr = pr * pr - pi * pi; pi = 2.f * pr * pi; pr = tr; }
    o.lr = lr; o.li = li; o.pr = pr; o.pi = pi;
    if (OUT) {
#pragma unroll
        for (int kk = 0; kk < 4; ++kk) { const size_t off = (size_t)(g * 16 + fr) * 64 + kk * 16 + 4 * fq;
            const f32x4 cr = *(const f32x4*)(a.in[15] + off), ci = *(const f32x4*)(a.in[16] + off);
            const u32x4 w = (u32x4){pk2(cr[0], -ci[0]), pk2(cr[1], -ci[1]), pk2(cr[2], -ci[2]), pk2(cr[3], -ci[3])};
            o.cf[kk] = __builtin_bit_cast(bf16x8, w); }
        o.dsk = *(const f32x4*)(a.in[17] + g * 16 + 4 * fq);
    } else { o.dsk = (f32x4){0.f, 0.f, 0.f, 0.f};
#pragma unroll
        for (int kk = 0; kk < 4; ++kk) o.cf[kk] = (bf16x8){0, 0, 0, 0, 0, 0, 0, 0}; }
    return o;
}

template <bool OUT>
__device__ __forceinline__ void ssm_item(const Args& a, const bf16* Podd, float2* E, bf16* Y, LAS unsigned char* lds, int item, int wave, int lane, const SsmOps o) {
    const int g = item & 63, c = (item >> 6) & 63, b = item >> 12, n = lane;
    const float lr = o.lr, li = o.li;
    const size_t tok0 = (size_t)b * SEQ + c * 64;
    const int fr = lane & 15, fq = lane >> 4;
    LAS unsigned char* tile = lds + wave * SSM_TILEB;
    LAS unsigned* Sw = (LAS unsigned*)tile;
    bf16x8 ub[4];
    const bf16x8 zero8 = (bf16x8){0, 0, 0, 0, 0, 0, 0, 0};
#pragma unroll
    for (int tt = 0; tt < 4; ++tt) ub[tt] = (fq < 2) ? *(const bf16x8*)(Podd + (tok0 + tt * 16 + fr) * 2048 + g * 16 + 8 * fq) : zero8;
    float sr = 0.f, si = 0.f;
    if (OUT) {
        const float pr = o.pr, pi = o.pi;
        const float2* Ep = E + ((size_t)(b * 64) * 64 + g) * 64 + n;
        for (int c0 = 0; c0 < c; c0 += 16) {
            float2 e[16];
#pragma unroll
            for (int k = 0; k < 16; ++k) { const int cc = (c0 + k < c) ? c0 + k : c - 1; e[k] = Ep[(size_t)cc * 4096]; }
#pragma unroll
            for (int k = 0; k < 16; ++k) if (c0 + k < c) { const float tr = pr * sr - pi * si + e[k].x; si = pr * si + pi * sr + e[k].y; sr = tr; }
        }
    }
#pragma unroll
    for (int tt = 0; tt < 4; ++tt)
#pragma unroll
        for (int nt = 0; nt < 8; ++nt) { const f32x4 d = mfma16(o.af[nt], ub[tt], (f32x4){0.f, 0.f, 0.f, 0.f});
            *(LAS u32x2*)(tile + (tt * 16 + fr) * SSM_ROWB + (nt * 16 + 4 * fq) * 2) = (u32x2){pk2(d[0], d[1]), pk2(d[2], d[3])}; }
    f2v s = (f2v){sr, si};
    const f2v lam_a = (f2v){lr, lr}, lam_b = (f2v){-li, li};
    for (int t0 = 0; t0 < 64; t0 += 8) {
        unsigned bw[8];
#pragma unroll
        for (int k = 0; k < 8; ++k) bw[k] = Sw[(t0 + k) * (SSM_ROWB / 4) + n];
#pragma unroll
        for (int k = 0; k < 8; ++k) { const f2v bu = (f2v){bf_lo(bw[k]), bf_hi(bw[k])};
            s = lam_a * s + (lam_b * (f2v){s.y, s.x} + bu);
            if (OUT) Sw[(t0 + k) * (SSM_ROWB / 4) + n] = pk2(s.x, s.y); }
    }
    if (!OUT) { E[((size_t)(b * 64 + c) * 64 + g) * 64 + n] = make_float2(s.x, s.y); }
    else {
        const f32x4 dsk = o.dsk;
        const LAS unsigned char* Sr = lds + wave * SSM_TILEB + fr * SSM_ROWB + fq * 16;
#pragma unroll
        for (int tt = 0; tt < 4; ++tt) {
            f32x4 acc = (f32x4){0.f, 0.f, 0.f, 0.f};
#pragma unroll
            for (int kk = 0; kk < 4; ++kk) { const bf16x8 sf = *(const LAS bf16x8*)(Sr + tt * 16 * SSM_ROWB + kk * 64); acc = mfma16(o.cf[kk], sf, acc); }
            const size_t tok = tok0 + tt * 16 + fr;
            const u32x2 uu = *(const u32x2*)(Podd + tok * 2048 + g * 16 + 4 * fq);
            const float y0 = pg8::gelu_f(acc[0] + dsk[0] * bf_lo(uu.x)), y1 = pg8::gelu_f(acc[1] + dsk[1] * bf_hi(uu.x));
            const float y2 = pg8::gelu_f(acc[2] + dsk[2] * bf_lo(uu.y)), y3 = pg8::gelu_f(acc[3] + dsk[3] * bf_hi(uu.y));
            *(u32x2*)(Y + tok * 1024 + g * 16 + 4 * fq) = (u32x2){pk2(y0, y1), pk2(y2, y3)};
        }
    }
}

__device__ __forceinline__ void rowstat_item(const bf16* VT2, float* RSTD, LAS float* red, int item, int tid) {
    const int tg = tid & 7, cs = tid >> 3;
    const bf16* p = VT2 + (size_t)(cs * 16) * NT + item * 64 + tg * 8;
    u32x4 r[16];
#pragma unroll
    for (int c = 0; c < 16; ++c) r[c] = *(const u32x4*)(p + (size_t)c * NT);
    float s[8];
#pragma unroll
    for (int e = 0; e < 8; ++e) s[e] = 0.f;
#pragma unroll
    for (int c = 0; c < 16; ++c)
#pragma unroll
        for (int e = 0; e < 4; ++e) { const float lo = bf_lo(r[c][e]), hi = bf_hi(r[c][e]); s[2 * e] = fmaf(lo, lo, s[2 * e]); s[2 * e + 1] = fmaf(hi, hi, s[2 * e + 1]); }
#pragma unroll
    for (int e = 0; e < 8; ++e) red[cs * 64 + tg * 8 + e] = s[e];
    __syncthreads();
    if (tid < 64) { float tsum = 0.f;
#pragma unroll 8
        for (int w = 0; w < 64; ++w) tsum += red[w * 64 + tid];
        RSTD[item * 64 + tid] = 1.f / sqrtf(tsum * (1.f / 1024.f) + EPS); }
    __syncthreads();
}
__device__ __forceinline__ void sgu_item(const Args& a, const bf16* Podd, const bf16* VT2, const float* RSTD, bf16* MIX, int item, int wave  , int lane) {
    const int fr = lane & 15, fq = lane >> 4;
    const int h = item & 7, nb = item >> 3, tok0 = nb * 128, trow = wave * 16 + fr;
    f32x4 acc[8];
#pragma unroll
    for (int dt = 0; dt < 8; ++dt) acc[dt] = (f32x4){0.f, 0.f, 0.f, 0.f};
    const int nk = (wave * 16 + 15) / 32 + 1;
    const float* sw = a.in[21] + ((size_t)h * 128 + trow) * 128 + fq * 8;
    const float* rp = RSTD + tok0 + fq * 8;
    const bf16* vp = VT2 + (size_t)(h * 128 + fr) * NT + tok0 + fq * 8;
    const float bs = a.in[22][h * 128 + trow];
    const size_t tok = (size_t)tok0 + trow;
    f32x4 gn[8]; u32x2 uu[8];
#pragma unroll
    for (int dt = 0; dt < 8; ++dt) { const int d = h * 128 + dt * 16 + 4 * fq; gn[dt] = *(const f32x4*)(a.in[20] + d); uu[dt] = *(const u32x2*)(Podd + tok * 2048 + 1024 + d); }
    f32x4 w0 = *(const f32x4*)(sw), w1 = *(const f32x4*)(sw + 4), r0 = *(const f32x4*)(rp), r1 = *(const f32x4*)(rp + 4);
    bf16x8 vf[8];
#pragma unroll
    for (int dt = 0; dt < 8; ++dt) vf[dt] = *(const bf16x8*)(vp + (size_t)dt * 16 * NT);
    for (int kk = 0; kk < nk; ++kk) {
        const int kn = (kk + 1 < nk) ? kk + 1 : kk;
        const f32x4 nw0 = *(const f32x4*)(sw + kn * 32), nw1 = *(const f32x4*)(sw + kn * 32 + 4), nr0 = *(const f32x4*)(rp + kn * 32), nr1 = *(const f32x4*)(rp + kn * 32 + 4);
        bf16x8 nvf[8];
#pragma unroll
        for (int dt = 0; dt < 8; ++dt) nvf[dt] = *(const bf16x8*)(vp + kn * 32 + (size_t)dt * 16 * NT);
        float wv[8];
#pragma unroll
        for (int e = 0; e < 4; ++e) { const int s = kk * 32 + fq * 8 + e; wv[e] = (s <= trow) ? w0[e] * r0[e] : 0.f; wv[4 + e] = (s + 4 <= trow) ? w1[e] * r1[e] : 0.f; }
        u32x4 wp; wp.x = pk2(wv[0], wv[1]); wp.y = pk2(wv[2], wv[3]); wp.z = pk2(wv[4], wv[5]); wp.w = pk2(wv[6], wv[7]);
        const bf16x8 wf = __builtin_bit_cast(bf16x8, wp);
#pragma unroll
        for (int dt = 0; dt < 8; ++dt) acc[dt] = mfma16(vf[dt], wf, acc[dt]);
        w0 = nw0; w1 = nw1; r0 = nr0; r1 = nr1;
#pragma unroll
        for (int dt = 0; dt < 8; ++dt) vf[dt] = nvf[dt];
    }
#pragma unroll
    for (int dt = 0; dt < 8; ++dt) { const int d = h * 128 + dt * 16 + 4 * fq;
        const float o0 = bf_lo(uu[dt].x) * (gn[dt][0] * acc[dt][0] + bs), o1 = bf_hi(uu[dt].x) * (gn[dt][1] * acc[dt][1] + bs);
        const float o2 = bf_lo(uu[dt].y) * (gn[dt][2] * acc[dt][2] + bs), o3 = bf_hi(uu[dt].y) * (gn[dt][3] * acc[dt][3] + bs);
        *(u32x2*)(MIX + tok * DM + 1024 + d) = (u32x2){pk2(o0, o1), pk2(o2, o3)}; }
}

__global__ void __launch_bounds__(512, 2) fwd(Args a) {
    extern __shared__ __attribute__((aligned(16))) unsigned char lds_raw[];
    LAS unsigned char* lds = (LAS unsigned char*)lds_raw;
    cg::grid_group grid = cg::this_grid();
    const int G = gridDim.x, bx = blockIdx.x, NGW = G * 8;
    unsigned char* ws = a.ws;
    bf16* const HN = (bf16*)(ws + WS_HN); bf16* const MIX = (bf16*)(ws + WS_MIX); bf16* const Fb = (bf16*)(ws + WS_F); bf16* const BIG = (bf16*)(ws + WS_BIG);
    bf16* const VT = (bf16*)(ws + WS_BIG + BIG_VT); bf16* const VT2 = (bf16*)(ws + WS_BIG + BIG_VT2); bf16* const Yb = (bf16*)(ws + WS_BIG + BIG_Y);
    float2* const Eb = (float2*)(ws + WS_BIG + BIG_E); float* const RSTD = (float*)(ws + WS_BIG + BIG_RSTD);
    const float* normg = a.in[1];
    volatile LAS unsigned* MISC = (volatile LAS unsigned*)(lds + LDS_BYTES - 64);
    if (threadIdx.x < 16) MISC[threadIdx.x] = 0u;
    __syncthreads();
    XcdBarrier xbar; xbar.bar = (unsigned*)ws + CW_BAR; xbar.x = 0; xbar.st = nullptr;
    if (a.ph_hi - a.ph_lo > 1) xbar = xcd_barrier_post((unsigned*)ws + CW_BAR, MISC);

    unsigned long long tph0 = 0;
    for (int ph = a.ph_lo; ph < a.ph_hi; ++ph) {
        bool did = true;
#if MK_TPH >= 0
        if (ph == MK_TPH && bx == 0 && threadIdx.x == 0) tph0 = __builtin_amdgcn_s_memrealtime();
#endif
        int tid_ = threadIdx.x; asm volatile("" : "+v"(tid_));
        const int lane = tid_ & 63, wave = __builtin_amdgcn_readfirstlane(tid_ >> 6), gw = bx * 8 + wave;
        if (ph == 0) {
#ifndef NO_CONV
            phase_conv(a, lds, gw, NGW, wave, lane);
#endif
            phase_row(a.in[0], nullptr, nullptr, nullptr, 0.f, nullptr, nullptr, normg, HN, gw, NGW, lane, 0u);
        } else {
            const int i = (ph - 1) / 12, s = (ph - 1) % 12;
            const float* ng = normg + (size_t)i * 6 * DM;
            if (s == 0 || s == 9) {
                const int lf = i * 2 + (s == 9);
                pg8::Gemm g{HN, (const bf16*)(ws + WS_WGU) + (size_t)lf * 11264 * 2048, NT, 11264, DM}; pg8::StaticOrder S; S.init(NT, 11264, G, bx);
                pg8::EpiSwiglu E{BIG, FF};
#ifndef NO_G1
                pg8::gemm_phase<pg8::EpiSwiglu, pg8::StaticOrder, MK_ALIGN, MK_SP2>(lds, g, S, E);
#endif
            } else if (s == 1 || s == 10 || s == 7) {
                const int lf = i * 2 + (s == 10);
                const bf16* A = (s == 7) ? MIX : BIG; const int K = (s == 7) ? DM : FF;
                const bf16* Bt = (s == 7) ? (const bf16*)(ws + (i == 0 ? WS_WEOUT : WS_WOOUT)) : (const bf16*)(ws + WS_WD) + (size_t)lf * 2048 * 5632;
                pg8::Gemm g{A, Bt, NT, DM, K}; pg8::StaticOrder S; S.init(NT, DM, G, bx);
                pg8::EpiBf16<0> E{Fb, DM, nullptr, 0, 0, 1.f};
#ifndef NO_G2
                pg8::gemm_phase<pg8::EpiBf16<0>, pg8::StaticOrder, MK_ALIGN, MK_SP2>(lds, g, S, E);
#endif
            } else if (s == 2 || s == 8 || s == 11) {
                const int kf = (s == 2) ? 1 : (s == 8) ? 3 : 5;
                const float* gH = (s == 11) ? (i == 0 ? normg + 6 * DM : nullptr) : ng + (size_t)(kf + 1) * DM;
                unsigned npert = 0u;
#if MK_TPH != -1
                npert = (MK_TPH == -2) ? (1u << 20) : ((const volatile unsigned*)ws)[2048];
#endif
#if MK_XBF16
                bf16* const XB = (bf16*)(ws + WS_XB);
                phase_row(a.in[0], (ph == 3) ? nullptr : XB, Fb, ng + (size_t)kf * DM, (s == 8) ? 1.0f : 0.5f, a.out, (ph == N_PHASES - 1) ? nullptr : XB, gH, HN, gw, NGW, lane, npert);
#else
                phase_row((ph == 3) ? a.in[0] : a.out, nullptr, Fb, ng + (size_t)kf * DM, (s == 8) ? 1.0f : 0.5f, a.out, nullptr, gH, HN, gw, NGW, lane, npert);
#endif
            } else if (s == 3) {
                const int N = (i == 0) ? 5120 : 3072;
                pg8::Gemm g{HN, (const bf16*)(ws + (i == 0 ? WS_WEIN : WS_WOIN)), NT, N, DM}; pg8::StaticOrder S; S.init(NT, N, G, bx);
                pg8::EpiIn E{BIG, (i == 0) ? 3584 : 2048, (i == 0) ? VT : VT2, NT, (i == 0) ? 3584 : 2048, (i == 0) ? (1 << 30) : 1024};
#ifndef NO_G3
                pg8::gemm_phase<pg8::EpiIn, pg8::StaticOrder, MK_ALIGN, MK_SP2>(lds, g, S, E);
#endif
            } else if (s == 4) {
                if (i == 0) {
#ifndef NO_POOL
                    for (int it = bx; it < 512; it += G) pool_item(a, BIG, (const bf16*)(ws + WS_PWT), MIX, it, wave, lane);
                    for (int it = bx; it < 4 * 12 * 32; it += G) attn_wg_item(BIG, VT, MIX, lds, it, wave, lane, tid_);
#endif
                } else {
#ifndef NO_SSM
                    for (int it = bx; it < 256; it += G) rowstat_item(VT2, RSTD, (LAS float*)lds, it, tid_);
                    if ((NGW & 63) == 0) { const SsmOps ops = ssm_setup<false>(a, lds, wave, gw & 63, lane);
                      for (int it = gw; it < 4 * 64 * 64; it += NGW) ssm_item<false>(a, BIG, Eb, Yb, lds, it, wave, lane, ops); }
                    else for (int it = gw; it < 4 * 64 * 64; it += NGW) ssm_item<false>(a, BIG, Eb, Yb, lds, it, wave, lane, ssm_setup<false>(a, lds, wave, it & 63, lane));
#endif
                }
            } else if (s == 5) {
                if (i == 1) {
#ifndef NO_SSM3
#if MK_TPH == 100
                    unsigned long long tq0 = __builtin_amdgcn_s_memrealtime();
#endif
                    for (int it = bx; it < 512; it += G) { sgu_item(a, BIG, VT2, RSTD, MIX, 2 * it, wave, lane); sgu_item(a, BIG, VT2, RSTD, MIX, 2 * it + 1, 7 - wave, lane); }
#if MK_TPH == 100
                    __syncthreads(); if (bx == 0 && threadIdx.x == 0) ((unsigned*)ws)[2048] = (unsigned)((__builtin_amdgcn_s_memrealtime() - tq0) * 16ull);
#endif
                    if ((NGW & 63) == 0) { const SsmOps ops = ssm_setup<true>(a, lds, wave, gw & 63, lane);
                      for (int it = gw; it < 4 * 64 * 64; it += NGW) ssm_item<true>(a, BIG, Eb, Yb, lds, it, wave, lane, ops); }
                    else for (int it = gw; it < 4 * 64 * 64; it += NGW) ssm_item<true>(a, BIG, Eb, Yb, lds, it, wave, lane, ssm_setup<true>(a, lds, wave, it & 63, lane));
#endif
                } else did = false;
            } else {
                if (i == 1) {
                    pg8::Gemm g{Yb, (const bf16*)(ws + WS_WGLU), NT, 1024, 1024}; pg8::StaticOrder S; S.init(NT, 1024, G, bx);
                    pg8::EpiGlu E{Yb, 1024, a.in[19], MIX, DM};
#ifndef NO_G4
                    pg8::gemm_phase<pg8::EpiGlu, pg8::StaticOrder, MK_ALIGN, MK_SP2>(lds, g, S, E);
#endif
                } else did = false;
            }
        }
        if (did && ph + 1 < a.ph_hi) { if (a.ph_hi > N_PHASES) grid.sync(); else xcd_barrier(xbar); }
#if MK_TPH >= 0
        if (ph == MK_TPH_END && bx == 0 && threadIdx.x == 0) { ((unsigned*)ws)[2048] = (unsigned)((__builtin_amdgcn_s_memrealtime() - tph0) * 16ull); }
#endif
#if MK_XSYNC
        if (ph >= 1 && ph <= 5) { for (int q = 0; q < 4; ++q) grid.sync(); }
#endif
#if MK_DUPMASK
        if (!(a.dup_done) && ((MK_DUPMASK >> ph) & 1)) { a.dup_done = 1; --ph; } else a.dup_done = 0;
#endif
    }
}


#if MK_CHECK
__device__ __forceinline__ float bfv(const bf16* p, size_t i) { return bf_lo((unsigned)p[i]); }
__device__ __forceinline__ void chk_flag(unsigned* flags, int bit, float fast, float ref) { if (!(fabsf(fast - ref) <= 0.03f * fabsf(ref) + 0.03f)) atomicOr(flags, 1u << bit); }
__global__ void chk(Args a, int which) {
    unsigned char* ws = a.ws; unsigned* flags = (unsigned*)ws;
    const bf16* HN = (const bf16*)(ws + WS_HN); const bf16* MIX = (const bf16*)(ws + WS_MIX); const bf16* BIG = (const bf16*)(ws + WS_BIG);
    const bf16* VT = (const bf16*)(ws + WS_BIG + BIG_VT); const bf16* VT2 = (const bf16*)(ws + WS_BIG + BIG_VT2); const bf16* Yb = (const bf16*)(ws + WS_BIG + BIG_Y);
    const int i = threadIdx.x; const unsigned hsh = (unsigned)(i + 1) * 2654435761u;
    unsigned long long* slots = (unsigned long long*)(ws + 4096);
    if (which == 100) { if (i == 0) *flags = 0u; slots[i] = 0ull; return; }
    if (which == 101) { if (i == 0) { unsigned f = 0; for (int p = 0; p < 6; ++p) if (slots[2 * p] != slots[2 * p + 1]) f |= 1u << p; a.out[0] = 1000.f + 100.f * (float)f; } return; }
    if (which == 0) {
        const int row = hsh % NT, col = (hsh >> 7) % FF; float g = 0.f, u = 0.f;
        for (int k = 0; k < DM; ++k) { const float h = bfv(HN, (size_t)row * DM + k); g += h * a.in[2][(size_t)k * FF + col]; u += h * a.in[3][(size_t)k * FF + col]; }
        chk_flag(flags, 0, bfv(BIG, (size_t)row * FF + col), g / (1.f + expf(-g)) * u);
    } else if (which == 1) {
        const int row = hsh % NT, col = (i < 32) ? (hsh >> 7) % 3584 : 3584 + (hsh >> 7) % 1536; float p = 0.f;
        for (int k = 0; k < DM; ++k) p += bfv(HN, (size_t)row * DM + k) * a.in[5][(size_t)k * 5120 + col];
        chk_flag(flags, 1, col < 3584 ? bfv(BIG, (size_t)row * 3584 + col) : bfv(VT, (size_t)(col - 3584) * NT + row), p);
    } else if (which == 2) {
        const int tok = (i < 8) ? i * 4096 / 2 + i : hsh % NT, c = (hsh >> 9) % 512, g = c >> 7, d = c & 127, W = 2 << g, tpos = tok & 4095;
        const int nwin = tpos + 1 < W ? tpos + 1 : W; float y = 0.f;
        for (int cc = 0; cc < 128; ++cc) { float sm = 0.f; for (int q = 0; q < nwin; ++q) sm += bfv(BIG, (size_t)(tok - q) * 3584 + g * 128 + cc);
            y += (sm / nwin - bfv(BIG, (size_t)tok * 3584 + g * 128 + cc)) * a.in[6][((size_t)g * 128 + cc) * 128 + d]; }
        chk_flag(flags, 2, bfv(MIX, (size_t)tok * DM + c), y * a.in[7][c]);
    } else if (which == 3) {
        const int b = i & 3, h = (hsh >> 5) % 12, d = (hsh >> 11) & 127; const int t = (i < 16) ? i * 3 : (hsh >> 3) % 4096; const size_t tb = (size_t)b * 4096;
        float later = 0.f, acc = 0.f;
        for (int sidx = t - 1; sidx >= 0; --sidx) { float z = 0.f;
            for (int k = 0; k < 128; ++k) z += bfv(BIG, (tb + t) * 3584 + 512 + h * 128 + k) * bfv(BIG, (tb + sidx) * 3584 + 2048 + h * 128 + k);
            z *= 0.08838834764831845f;
            const float sp = log1pf(expf(-fabsf(z))); const float lsp = fminf(z, 0.f) - sp, lsn = -(fmaxf(z, 0.f) + sp);
            acc += expf(lsp + later) * bfv(VT, (size_t)(h * 128 + d) * NT + tb + sidx); later += lsn; if (later < -200.f) break; }
        chk_flag(flags, 3, bfv(MIX, (tb + t) * DM + 512 + h * 128 + d), acc);
        if (!(fabsf(bfv(MIX, (tb + t) * DM + 512 + h * 128 + d) - acc) <= 0.3f)) atomicOr(flags, 1u << 4);
    } else if (which == 4) {
        const int b = i & 3, g = (hsh >> 5) & 63, ch = (hsh >> 12) & 15; const int t = (i < 8) ? i * 9 : (i < 24 ? 60 + i * 7 : (hsh >> 3) % 1500); const size_t tb = (size_t)b * 4096;
        const float dt = expf(a.in[12][g]); float y = 0.f;
        for (int n = 0; n < 64; ++n) {
            const float are = a.in[10][g * 64 + n], aim = a.in[11][g * 64 + n]; const float mag = expf(are * dt); float sn, cs; sincos_f(aim * dt, sn, cs);
            const float lr = mag * cs, li = mag * sn, den = are * are + aim * aim, nr = lr - 1.f; const float fre = (nr * are + li * aim) / den, fim = (li * are - nr * aim) / den;
            float sr = 0.f, si = 0.f;
            for (int q = 0; q <= t; ++q) { float bur = 0.f, bui = 0.f;
                for (int c = 0; c < 16; ++c) { const float br = a.in[13][(size_t)(g * 64 + n) * 16 + c], bi = a.in[14][(size_t)(g * 64 + n) * 16 + c], u = bfv(BIG, (tb + q) * 2048 + g * 16 + c);
                    bur += (fre * br - fim * bi) * u; bui += (fre * bi + fim * br) * u; }
                const float nsr = lr * sr - li * si + bur; si = lr * si + li * sr + bui; sr = nsr; }
            y += a.in[15][(size_t)(g * 16 + ch) * 64 + n] * sr - a.in[16][(size_t)(g * 16 + ch) * 64 + n] * si; }
        y += a.in[17][g * 16 + ch] * bfv(BIG, (tb + t) * 2048 + g * 16 + ch);
        chk_flag(flags, 4, bfv(Yb, (tb + t) * 1024 + g * 16 + ch), pg8::gelu_f(y));
    } else if (which == 6) {
        const bf16* Fb = (const bf16*)(ws + WS_F); const int row = hsh % NT, col = (hsh >> 7) % DM; float f = 0.f;
        for (int k = 0; k < FF; ++k) f += bfv(BIG, (size_t)row * FF + k) * a.in[4][(size_t)k * DM + col];
        chk_flag(flags, 0, bfv(Fb, (size_t)row * DM + col), f);
    } else if (which == 7) {
        const bf16* Fb = (const bf16*)(ws + WS_F); const int row = 1 + hsh % (NT - 1), col = (hsh >> 7) % DM; float ss = 0.f, s2 = 0.f;
        for (int k = 0; k < DM; ++k) { const float f = bfv(Fb, (size_t)row * DM + k); ss += f * f; const float o = a.out[(size_t)row * DM + k]; s2 += o * o; }
        const float xn = a.in[0][(size_t)row * DM + col] + 0.5f * bfv(Fb, (size_t)row * DM + col) / sqrtf(ss / DM + EPS) * a.in[1][1 * DM + col];
        chk_flag(flags, 1, a.out[(size_t)row * DM + col], xn);
        chk_flag(flags, 1, bfv(HN, (size_t)row * DM + col), a.out[(size_t)row * DM + col] / sqrtf(s2 / DM + EPS) * a.in[1][2 * DM + col]);
    } else if (which == 8) {
        const bf16* Fb = (const bf16*)(ws + WS_F); const int row = hsh % NT, col = (hsh >> 7) % DM; float f = 0.f;
        for (int k = 0; k < DM; ++k) f += bfv(MIX, (size_t)row * DM + k) * a.in[8][(size_t)k * DM + col];
        chk_flag(flags, 2, bfv(Fb, (size_t)row * DM + col), f);
    } else if (which == 9) {
        const int row = hsh % NT, col = (hsh >> 7) % 1024; float f = a.in[19][col];
        for (int k = 0; k < 1024; ++k) f += bfv(Yb, (size_t)row * 1024 + k) * a.in[18][(size_t)k * 1024 + col];
        chk_flag(flags, 5, bfv(MIX, (size_t)row * DM + col), bfv(Yb, (size_t)row * 1024 + col) / (1.f + expf(-f)));
    } else if (which == 5) {
        const int tok = hsh % NT, h = (hsh >> 4) & 7, d = (hsh >> 9) & 127, t = tok & 127, tok0 = tok - t; float m = 0.f;
        for (int sidx = 0; sidx <= t; ++sidx) { float ss = 0.f; for (int c = 0; c < 1024; ++c) { const float v = bfv(VT2, (size_t)c * NT + tok0 + sidx); ss += v * v; }
            m += a.in[21][((size_t)h * 128 + t) * 128 + sidx] * bfv(VT2, (size_t)(h * 128 + d) * NT + tok0 + sidx) / sqrtf(ss / 1024.f + EPS); }
        const float o = bfv(BIG, (size_t)tok * 2048 + 1024 + h * 128 + d) * (a.in[20][h * 128 + d] * m + a.in[22][h * 128 + t]);
        chk_flag(flags, 5, bfv(MIX, (size_t)tok * DM + 1024 + h * 128 + d), o);
    }
}
#endif

#if MK_CHECK
__global__ void cks(const unsigned* buf, size_t nwords, unsigned long long* slot) {
    unsigned long long sum = 0; const size_t stride = (size_t)gridDim.x * blockDim.x;
    for (size_t i = (size_t)blockIdx.x * blockDim.x + threadIdx.x; i < nwords; i += stride) sum += (unsigned long long)buf[i] * (1 + (i & 1023));
    atomicAdd(slot, sum);
}
#endif
extern "C" void kernel_launch(void* const* d_in, const int* in_sizes, int n_in, void* d_out, int out_size, void* d_ws, size_t ws_size, hipStream_t stream) {
    static int grid = 0;
    if (grid == 0) {
        if (n_in != 24 || ws_size < WS_END) { fprintf(stderr, "kernel_launch: unexpected n_in %d or ws_size %zu (< %zu)\n", n_in, ws_size, (size_t)WS_END); grid = -1; return; }
        int dev = 0, cus = 0, per_cu = 0;
        (void)hipGetDevice(&dev); (void)hipDeviceGetAttribute(&cus, hipDeviceAttributeMultiprocessorCount, dev);
        if (hipFuncSetAttribute((const void*)fwd, hipFuncAttributeMaxDynamicSharedMemorySize, LDS_BYTES) != hipSuccess) { fprintf(stderr, "kernel_launch: hipFuncSetAttribute failed\n"); grid = -1; return; }
        if (hipOccupancyMaxActiveBlocksPerMultiprocessor(&per_cu, (const void*)fwd, 512, LDS_BYTES) != hipSuccess || per_cu < 1) per_cu = 1;
        (void)hipGetLastError();
        grid = cus * per_cu;
        if (grid <= 0) grid = 256;
    }
    if (grid < 0) return;
    Args a{};
    for (int i = 0; i < 24; ++i) a.in[i] = (const float*)d_in[i];
    a.out = (float*)d_out; a.ws = (unsigned char*)d_ws;
#if MK_MULTI
    for (int ph = 0; ph < MK_STOP; ++ph) {
        if (ph == 6 || ph == 7) continue;
        a.ph_lo = ph; a.ph_hi = ph + 1;
        hipLaunchKernelGGL(fwd, dim3(grid), dim3(512), LDS_BYTES, stream, a);
#if MK_CHECK
        {
            unsigned char* w8 = (unsigned char*)d_ws; unsigned long long* slots = (unsigned long long*)(w8 + 4096);
            if (ph == 0) hipLaunchKernelGGL(chk, dim3(1), dim3(64), 0, stream, a, 100);
            int pair = -1; const unsigned* buf = nullptr; size_t nw = 0;
            if (ph == 1) { pair = 0; buf = (const unsigned*)(w8 + WS_BIG); nw = (size_t)NT * FF / 2; }
            if (ph == 2) { pair = 1; buf = (const unsigned*)(w8 + WS_F); nw = (size_t)NT * DM / 2; }
            if (ph == 4) { pair = 2; buf = (const unsigned*)(w8 + WS_BIG); nw = (size_t)160 * MiB / 4; }
            if (ph == 5) { pair = 3; buf = (const unsigned*)(w8 + WS_MIX); nw = (size_t)NT * DM / 2; }
            if (ph == 8) { pair = 4; buf = (const unsigned*)(w8 + WS_F); nw = (size_t)NT * DM / 2; }
            if (ph == 3) { pair = 5; buf = (const unsigned*)(w8 + WS_HN); nw = (size_t)NT * DM / 2; }
            if (pair >= 0) {
                hipLaunchKernelGGL(cks, dim3(1024), dim3(256), 0, stream, buf, nw, slots + 2 * pair);
                if (ph != 3) hipLaunchKernelGGL(fwd, dim3(grid), dim3(512), LDS_BYTES, stream, a);
                hipLaunchKernelGGL(cks, dim3(1024), dim3(256), 0, stream, buf, nw, slots + 2 * pair + 1);
            }
            if (ph == N_PHASES - 1) hipLaunchKernelGGL(chk, dim3(1), dim3(64), 0, stream, a, 101);
        }
#endif
    }
#else
    a.ph_lo = 0; a.ph_hi = N_PHASES;
    (void)hipMemsetAsync(d_ws, 0, 65536, stream);
    void* args[] = {&a};
    hipError_t e = hipLaunchCooperativeKernel((const void*)fwd, dim3(grid), dim3(512), args, LDS_BYTES, stream);
    if (e != hipSuccess) fprintf(stderr, "kernel_launch: cooperative launch failed: %s (grid %d)\n", hipGetErrorString(e), grid);
#endif
}
```

```cpp
#include <hip/hip_runtime.h>
#include <hip/hip_cooperative_groups.h>
#include <cstdio>
#include <cstdint>
namespace cg = cooperative_groups;
namespace pg8 {
#define PG8_LAS __attribute__((address_space(3)))
typedef unsigned short bf16_t;
typedef short bf16x8 __attribute__((ext_vector_type(8)));
typedef float f32x4 __attribute__((ext_vector_type(4)));
typedef unsigned u32x4 __attribute__((ext_vector_type(4)));
constexpr int BM = 256, BK = 64, HALF = 128, HTB = HALF * BK * 2  , STAGE_BYTES = 8 * HTB, NXCD = 8, WGM = 8;

__host__ __device__ __forceinline__ int lds_byte(int r, int c) { const int st = (r >> 4) * 2 + (c >> 5), rr = r & 15, cc = c & 31, ob = rr * 64 + cc * 2; return st * 1024 + (ob ^ (((ob >> 9) & 1) << 5)); }
__host__ __device__ __forceinline__ void stage_rc(int b, int& R, int& C) { const int st = b / 1024, sb = b % 1024, swz = sb ^ (((sb >> 9) & 1) << 5); R = (st >> 1) * 16 + swz / 64; C = (st & 1) * 32 + (swz % 64) / 2; }
__host__ __device__ __forceinline__ int perm32(int rho) { const int n = rho >> 4, i = rho & 15; return 8 * (i >> 2) + 4 * n + (i & 3); }

struct Unit { int pm, pn; };
struct Gemm { const bf16_t* A; const bf16_t* Bt; int M, N, K; };

struct StaticOrder {
    int nM, nN, nwg, G, c;
    __host__ __device__ void init(int M, int N, int G_, int c_) { nM = M / BM; nN = N / BM; nwg = nM * nN; G = G_; c = c_; }
    __host__ __device__ bool next(int i, Unit& u) const {
        const long L = (long)i * G + c; if (L >= nwg) return false;
        int wgid = (int)L; { const int q = nwg / NXCD, r = nwg % NXCD, xcd = wgid % NXCD, off = wgid / NXCD; wgid = (xcd < r ? xcd * (q + 1) : r * (q + 1) + (xcd - r) * q) + off; }
        const int nig = WGM * nN, gid = wgid / nig, fm = gid * WGM, gsz = (nM - fm) < WGM ? (nM - fm) : WGM;
        u.pm = fm + ((wgid % nig) % gsz); u.pn = (wgid % nig) / gsz; return true;
    }
    __device__ __forceinline__ void a_ready(const Unit&) const {}
    __device__ __forceinline__ void done(const Unit&) const {}
};

__device__ __forceinline__ unsigned cvt_pk_bf16(float lo, float hi) { unsigned r; asm volatile("v_cvt_pk_bf16_f32 %0, %1, %2" : "=v"(r) : "v"(lo), "v"(hi)); return r; }
typedef float f32x2 __attribute__((ext_vector_type(2)));
__device__ __forceinline__ f32x2 gelu_pk(f32x2 v) {
    const f32x2 av = __builtin_elementwise_abs(v), d = av * 0.2316418882f + 1.0f;
    f32x2 t; t.x = __builtin_amdgcn_rcpf(d.x); t.y = __builtin_amdgcn_rcpf(d.y);
    f32x2 q = t * 0.5307027145f + (-0.7265760135f); q = q * t + 0.7107068705f; q = q * t + (-0.142248368f); q = q * t + 0.127414796f; q = q * t;
    const f32x2 s = (v * v) * (-0.72134752044f);
    f32x2 e; e.x = __builtin_amdgcn_exp2f(s.x); e.y = __builtin_amdgcn_exp2f(s.y);
    const f32x2 m = v * (q * e), r = v - m;
    f32x2 o; o.x = v.x < 0.f ? m.x : r.x; o.y = v.y < 0.f ? m.y : r.y; return o;
}

template <int ACT  > struct EpiBf16 {
    static constexpr bool PERM = true, AFTER_DRAIN = false; static_assert(ACT == 0 || ACT == 1, "EpiBf16: ACT is 0 (none) or 1 (gelu_pk)");
    bf16_t* O; int ldc; const float* bias; int split_cols; size_t split_stride; float scale0;
    __device__ __forceinline__ void operator()(const f32x4 (&acc)[2][2][4][2], const Unit& u, int wr, int wc, int fr, int fq) const {
        const int row0 = u.pm * BM + wr * 64 + fr; int colt = u.pn * BM; bf16_t* base = O;
        float sc = 1.f; if (split_cols) { const int t = colt / split_cols; base += (size_t)t * split_stride; colt -= t * split_cols; if (t == 0) sc = scale0; }
        const int col0 = colt + wc * 32 + 8 * fq, bcol0 = u.pn * BM + wc * 32 + 8 * fq;
        f32x4 bv[2][2];
#pragma unroll
        for (int bj = 0; bj < 2; ++bj)
#pragma unroll
            for (int n = 0; n < 2; ++n) bv[bj][n] = bias ? *(const f32x4*)(bias + bcol0 + bj * HALF + 4 * n) : (f32x4){0.f, 0.f, 0.f, 0.f};
#pragma unroll
        for (int ai = 0; ai < 2; ++ai)
#pragma unroll
            for (int m = 0; m < 4; ++m) { bf16_t* rowp = base + (size_t)(row0 + ai * HALF + m * 16) * ldc + col0;
#pragma unroll
                for (int bj = 0; bj < 2; ++bj) { f32x4 v0 = acc[ai][bj][m][0] + bv[bj][0], v1 = acc[ai][bj][m][1] + bv[bj][1];
                    if (ACT == 1) { f32x2 a = gelu_pk((f32x2){v0[0], v0[1]}), b = gelu_pk((f32x2){v0[2], v0[3]}), c = gelu_pk((f32x2){v1[0], v1[1]}), d = gelu_pk((f32x2){v1[2], v1[3]});
                        v0 = (f32x4){a.x, a.y, b.x, b.y}; v1 = (f32x4){c.x, c.y, d.x, d.y}; }
                    v0 = v0 * sc; v1 = v1 * sc; u32x4 w; w.x = cvt_pk_bf16(v0[0], v0[1]); w.y = cvt_pk_bf16(v0[2], v0[3]); w.z = cvt_pk_bf16(v1[0], v1[1]); w.w = cvt_pk_bf16(v1[2], v1[3]);
                    *(u32x4*)(rowp + bj * HALF) = w; } }
    }
};

__device__ __forceinline__ float sigm_f(float x) { return __builtin_amdgcn_rcpf(1.0f + __expf(-x)); }
__device__ __forceinline__ float silu_f(float x) { return x * sigm_f(x); }
__device__ __forceinline__ float gelu_f(float x) { return x * sigm_f(x * (1.5957691216f + 0.0713548163f * x * x)); }
__device__ __forceinline__ unsigned short f2bf_rne(float f) { unsigned u = __builtin_bit_cast(unsigned, f); return (unsigned short)((u + 0x7fffu + ((u >> 16) & 1u)) >> 16); }

__device__ __forceinline__ f32x2 silu_mul_pk(f32x2 g, f32x2 u) {
    const f32x2 e = g * (-1.4426950408889634f);
    f32x2 d; d.x = __builtin_amdgcn_exp2f(e.x); d.y = __builtin_amdgcn_exp2f(e.y);
    d = d + 1.0f;
    f32x2 r; r.x = __builtin_amdgcn_rcpf(d.x); r.y = __builtin_amdgcn_rcpf(d.y);
    return (g * u) * r;
}
struct EpiSwiglu {
    static constexpr bool PERM = true, AFTER_DRAIN = false;
    bf16_t* O; int ldc;
    __device__ __forceinline__ void operator()(const f32x4 (&acc)[2][2][4][2], const Unit& u, int wr, int wc, int fr, int fq) const {
        const int row0 = u.pm * BM + wr * 64 + fr, col0 = u.pn * HALF + wc * 32 + 8 * fq;
#pragma unroll
        for (int ai = 0; ai < 2; ++ai)
#pragma unroll
            for (int m = 0; m < 4; ++m) { bf16_t* rowp = O + (size_t)(row0 + ai * HALF + m * 16) * ldc + col0;
                const f32x4 g0 = acc[ai][0][m][0], g1 = acc[ai][0][m][1], u0 = acc[ai][1][m][0], u1 = acc[ai][1][m][1];
                const f32x2 a = silu_mul_pk((f32x2){g0[0], g0[1]}, (f32x2){u0[0], u0[1]}), b = silu_mul_pk((f32x2){g0[2], g0[3]}, (f32x2){u0[2], u0[3]});
                const f32x2 c = silu_mul_pk((f32x2){g1[0], g1[1]}, (f32x2){u1[0], u1[1]}), d = silu_mul_pk((f32x2){g1[2], g1[3]}, (f32x2){u1[2], u1[3]});
                u32x4 w; w.x = cvt_pk_bf16(a.x, a.y); w.y = cvt_pk_bf16(b.x, b.y); w.z = cvt_pk_bf16(c.x, c.y); w.w = cvt_pk_bf16(d.x, d.y);
                *(u32x4*)rowp = w; }
    }
};

struct EpiIn {
    static constexpr bool PERM = true, AFTER_DRAIN = false;
    bf16_t* O; int ldc; bf16_t* VT; int ldt; int split, gelu_from;
    __device__ __forceinline__ void operator()(const f32x4 (&acc)[2][2][4][2], const Unit& u, int wr, int wc, int fr, int fq) const {
        const int row0 = u.pm * BM + wr * 64 + fr, colt = u.pn * BM; const bool act = colt >= gelu_from;
        if (colt < split) {
            const int col0 = colt + wc * 32 + 8 * fq;
#pragma unroll
            for (int ai = 0; ai < 2; ++ai)
#pragma unroll
                for (int m = 0; m < 4; ++m) { bf16_t* rowp = O + (size_t)(row0 + ai * HALF + m * 16) * ldc + col0;
#pragma unroll
                    for (int bj = 0; bj < 2; ++bj) { f32x4 v0 = acc[ai][bj][m][0], v1 = acc[ai][bj][m][1];
                        if (act) {
#pragma unroll
                            for (int i = 0; i < 4; ++i) { v0[i] = gelu_f(v0[i]); v1[i] = gelu_f(v1[i]); } }
                        u32x4 w; w.x = cvt_pk_bf16(v0[0], v0[1]); w.y = cvt_pk_bf16(v0[2], v0[3]); w.z = cvt_pk_bf16(v1[0], v1[1]); w.w = cvt_pk_bf16(v1[2], v1[3]);
                        *(u32x4*)(rowp + bj * HALF) = w; } }
        } else {
            const int c0 = colt - split + wc * 32 + 8 * fq;
#pragma unroll
            for (int ai = 0; ai < 2; ++ai)
#pragma unroll
                for (int m = 0; m < 4; ++m) { const int row = row0 + ai * HALF + m * 16;
#pragma unroll
                    for (int bj = 0; bj < 2; ++bj)
#pragma unroll
                        for (int n = 0; n < 2; ++n) { f32x4 v = acc[ai][bj][m][n];
#pragma unroll
                            for (int i = 0; i < 4; ++i) { const float x = act ? gelu_f(v[i]) : v[i];
                                VT[(size_t)(c0 + bj * HALF + 4 * n + i) * ldt + row] = f2bf_rne(x); } } }
        }
    }
};

struct EpiGlu {
    static constexpr bool PERM = true, AFTER_DRAIN = false;
    const bf16_t* Y; int ldy; const float* bias; bf16_t* O; int ldc;
    __device__ __forceinline__ void operator()(const f32x4 (&acc)[2][2][4][2], const Unit& u, int wr, int wc, int fr, int fq) const {
        const int row0 = u.pm * BM + wr * 64 + fr, col0 = u.pn * BM + wc * 32 + 8 * fq;
#pragma unroll
        for (int ai = 0; ai < 2; ++ai)
#pragma unroll
            for (int m = 0; m < 4; ++m) { const int row = row0 + ai * HALF + m * 16;
#pragma unroll
                for (int bj = 0; bj < 2; ++bj) { const int col = col0 + bj * HALF;
                    const u32x4 yv = *(const u32x4*)(Y + (size_t)row * ldy + col);
                    const f32x4 b0 = *(const f32x4*)(bias + col), b1 = *(const f32x4*)(bias + col + 4);
                    const f32x4 v0 = acc[ai][bj][m][0] + b0, v1 = acc[ai][bj][m][1] + b1;
                    float y[8];
#pragma unroll
                    for (int i = 0; i < 4; ++i) { y[2 * i] = __builtin_bit_cast(float, yv[i] << 16); y[2 * i + 1] = __builtin_bit_cast(float, yv[i] & 0xffff0000u); }
                    u32x4 w; w.x = cvt_pk_bf16(y[0] * sigm_f(v0[0]), y[1] * sigm_f(v0[1])); w.y = cvt_pk_bf16(y[2] * sigm_f(v0[2]), y[3] * sigm_f(v0[3]));
                    w.z = cvt_pk_bf16(y[4] * sigm_f(v1[0]), y[5] * sigm_f(v1[1])); w.w = cvt_pk_bf16(y[6] * sigm_f(v1[2]), y[7] * sigm_f(v1[3]));
                    *(u32x4*)(O + (size_t)row * ldc + col) = w; } }
    }
};


template <class Epi, class Sched, bool ALIGN_EPI = false, bool SP2 = false>
__device__ __forceinline__ void gemm_phase(PG8_LAS unsigned char* lds, const Gemm g, const Sched& S, const Epi& E) {
    int tid_ = threadIdx.x; asm volatile("" : "+v"(tid_));
    const int tid = tid_, wid = __builtin_amdgcn_readfirstlane(tid >> 6), lane = tid & 63, wr = wid >> 2, wc = wid & 3, fr = lane & 15, fq = lane >> 4;
    const int K = g.K, nt = K / BK;
    unsigned voffA[2], voffB[2];
#pragma unroll
    for (int i = 0; i < 2; ++i) { int R, C; stage_rc(tid * 16 + i * 8192, R, C); const int Rb = Epi::PERM ? ((R & ~31) + perm32(R & 31)) : R;
        voffA[i] = (unsigned)(R * K + C) * 2u; voffB[i] = (unsigned)(Rb * K + C) * 2u; }
    const size_t kstep = (size_t)(BK * 2);
    const size_t hstep = (size_t)HALF * K * 2;
    const size_t tstep = 2 * hstep;
    const unsigned ldsw = (unsigned)wid * 1024u;
    const int aoff = lds_byte(wr * 64 + fr, fq * 8), boff = lds_byte(wc * 32 + fr, fq * 8);
#define PG8_SA(b, h) (((b) * 2 + (h)) * HTB)
#define PG8_SB(b, h) ((4 + (b) * 2 + (h)) * HTB)
#define PG8_STAGE(bufoff, gbase, voff) do { _Pragma("unroll") for (int _i = 0; _i < 2; ++_i) \
        __builtin_amdgcn_global_load_lds((const unsigned*)((const char*)(gbase) + (voff)[_i]), (PG8_LAS unsigned*)(lds + (bufoff) + ldsw + _i * 8192), 16, 0, 0); } while (0)
#define PG8_LDA(dst, b, h) do { _Pragma("unroll") for (int m = 0; m < 4; ++m) _Pragma("unroll") for (int k = 0; k < 2; ++k) dst[m][k] = *(const PG8_LAS bf16x8*)(lds + PG8_SA(b, h) + aoff + m * 2048 + k * 1024); } while (0)
#define PG8_LDB(dst, b, h) do { _Pragma("unroll") for (int n = 0; n < 2; ++n) _Pragma("unroll") for (int k = 0; k < 2; ++k) dst[n][k] = *(const PG8_LAS bf16x8*)(lds + PG8_SB(b, h) + boff + n * 2048 + k * 1024); } while (0)
#define PG8_MMA(ai, bj, At, Bt) do { __builtin_amdgcn_s_setprio(1); _Pragma("unroll") for (int m = 0; m < 4; ++m) _Pragma("unroll") for (int n = 0; n < 2; ++n) _Pragma("unroll") for (int k = 0; k < 2; ++k) \
        acc[ai][bj][m][n] = __builtin_amdgcn_mfma_f32_16x16x32_bf16(Bt[n][k], At[m][k], acc[ai][bj][m][n], 0, 0, 0); __builtin_amdgcn_s_setprio(0); } while (0)
#define PG8_WAIT_V(n) asm volatile("s_waitcnt vmcnt(" #n ")" ::: "memory")
#define PG8_WAIT_L(n) asm volatile("s_waitcnt lgkmcnt(" #n ")" ::: "memory")
#define PG8_BAR __builtin_amdgcn_s_barrier()
#define PG8_SCHED __builtin_amdgcn_sched_barrier(0)
    Unit cur, nxt; int ui = 0;
    if (!S.next(0, cur)) return;
    f32x4 acc[2][2][4][2];
#pragma unroll
    for (int a = 0; a < 2; ++a)
#pragma unroll
        for (int b = 0; b < 2; ++b)
#pragma unroll
            for (int m = 0; m < 4; ++m)
#pragma unroll
                for (int n = 0; n < 2; ++n) acc[a][b][m][n] = (f32x4){0.f, 0.f, 0.f, 0.f};
    bf16x8 At[4][2], B0[2][2], B1[2][2];
    const char* cA = (const char*)g.A + (size_t)cur.pm * tstep; const char* cB = (const char*)g.Bt + (size_t)cur.pn * tstep;
    S.a_ready(cur);
    if constexpr (SP2) {
        PG8_STAGE(PG8_SB(0, 0), cB, voffB); PG8_STAGE(PG8_SB(0, 1), cB + hstep, voffB); PG8_STAGE(PG8_SA(0, 0), cA, voffA); PG8_STAGE(PG8_SA(0, 1), cA + hstep, voffA);
        if (wr == 1) PG8_BAR;
        PG8_WAIT_V(2); PG8_BAR;
        PG8_STAGE(PG8_SB(1, 0), cB + kstep, voffB); PG8_STAGE(PG8_SA(1, 0), cA + kstep, voffA); PG8_STAGE(PG8_SB(1, 1), cB + hstep + kstep, voffB);
        PG8_WAIT_V(6); PG8_BAR;
    } else {
        PG8_STAGE(PG8_SB(0, 0), cB, voffB); PG8_STAGE(PG8_SA(0, 0), cA, voffA); PG8_STAGE(PG8_SB(0, 1), cB + hstep, voffB); PG8_STAGE(PG8_SA(0, 1), cA + hstep, voffA);
        if (wr == 1) PG8_BAR;
        PG8_WAIT_V(4); PG8_BAR;
        PG8_STAGE(PG8_SB(1, 0), cB + kstep, voffB); PG8_STAGE(PG8_SA(1, 0), cA + kstep, voffA); PG8_STAGE(PG8_SB(1, 1), cB + hstep + kstep, voffB);
        PG8_WAIT_V(6); PG8_BAR;
    }
    for (;;) {
        const bool has_next = S.next(ui + 1, nxt);
        const char* nA = has_next ? (const char*)g.A + (size_t)nxt.pm * tstep : cA; const char* nB = has_next ? (const char*)g.Bt + (size_t)nxt.pn * tstep : cB;
        for (int t = 0; t < nt; t += 2) {
            const bool last = (t == nt - 2);
            const char* a1 = cA + (size_t)(t + 1) * kstep;
            const char* a2 = last ? nA : cA + (size_t)(t + 2) * kstep; const char* b2 = last ? nB : cB + (size_t)(t + 2) * kstep;
            const char* a3 = a2 + kstep; const char* b3 = b2 + kstep;
            if (last && has_next) S.a_ready(nxt);
            if constexpr (SP2) {
            PG8_LDB(B0, 0, 0); PG8_LDB(B1, 0, 1); PG8_SCHED; PG8_LDA(At, 0, 0); PG8_STAGE(PG8_SA(1, 1), a1 + hstep, voffA);
            PG8_WAIT_V(8); PG8_WAIT_L(0); PG8_BAR; PG8_MMA(0, 0, At, B0); PG8_MMA(0, 1, At, B1); PG8_BAR; PG8_SCHED;
            PG8_LDA(At, 0, 1); PG8_STAGE(PG8_SB(0, 0), b2, voffB); PG8_STAGE(PG8_SB(0, 1), b2 + hstep, voffB); PG8_STAGE(PG8_SA(0, 0), a2, voffA);
            PG8_WAIT_V(8); PG8_WAIT_L(0); PG8_BAR; PG8_MMA(1, 0, At, B0); PG8_MMA(1, 1, At, B1); PG8_BAR; PG8_SCHED;
            PG8_LDB(B0, 1, 0); PG8_LDB(B1, 1, 1); PG8_SCHED; PG8_LDA(At, 1, 0); PG8_STAGE(PG8_SA(0, 1), a2 + hstep, voffA);
            PG8_WAIT_V(8); PG8_WAIT_L(0); PG8_BAR; PG8_MMA(0, 0, At, B0); PG8_MMA(0, 1, At, B1); PG8_BAR; PG8_SCHED;
            PG8_LDA(At, 1, 1); PG8_STAGE(PG8_SB(1, 0), b3, voffB); PG8_STAGE(PG8_SB(1, 1), b3 + hstep, voffB); PG8_STAGE(PG8_SA(1, 0), a3, voffA);
            PG8_WAIT_V(8); PG8_WAIT_L(0); PG8_BAR; PG8_MMA(1, 0, At, B0); PG8_MMA(1, 1, At, B1); PG8_BAR; PG8_SCHED;
            } else {
            PG8_LDB(B0, 0, 0); PG8_SCHED; PG8_LDA(At, 0, 0); PG8_STAGE(PG8_SA(1, 1), a1 + hstep, voffA);
            PG8_WAIT_L(8); PG8_BAR; PG8_WAIT_L(0); PG8_MMA(0, 0, At, B0); PG8_BAR; PG8_SCHED;
            PG8_LDB(B1, 0, 1); PG8_STAGE(PG8_SB(0, 0), b2, voffB);
            PG8_BAR; PG8_WAIT_L(0); PG8_MMA(0, 1, At, B1); PG8_BAR;
            PG8_LDA(At, 0, 1); PG8_STAGE(PG8_SA(0, 0), a2, voffA);
            PG8_BAR; PG8_WAIT_L(0); PG8_MMA(1, 0, At, B0); PG8_BAR; PG8_SCHED;
            PG8_STAGE(PG8_SB(0, 1), b2 + hstep, voffB);
            PG8_WAIT_V(6); PG8_BAR; PG8_MMA(1, 1, At, B1); PG8_BAR;
            PG8_LDB(B0, 1, 0); PG8_SCHED; PG8_LDA(At, 1, 0); PG8_STAGE(PG8_SA(0, 1), a2 + hstep, voffA);
            PG8_WAIT_L(8); PG8_BAR; PG8_WAIT_L(0); PG8_MMA(0, 0, At, B0); PG8_BAR; PG8_SCHED;
            PG8_LDB(B1, 1, 1); PG8_STAGE(PG8_SB(1, 0), b3, voffB);
            PG8_BAR; PG8_WAIT_L(0); PG8_MMA(0, 1, At, B1); PG8_BAR;
            PG8_LDA(At, 1, 1); PG8_STAGE(PG8_SA(1, 0), a3, voffA);
            PG8_BAR; PG8_WAIT_L(0); PG8_MMA(1, 0, At, B0); PG8_BAR; PG8_SCHED;
            PG8_STAGE(PG8_SB(1, 1), b3 + hstep, voffB);
            PG8_WAIT_V(6); PG8_BAR; PG8_MMA(1, 1, At, B1); PG8_BAR;
            }
        }
        if constexpr (ALIGN_EPI) { if (wr == 0) PG8_BAR; }
        if constexpr (!Epi::AFTER_DRAIN) { E(acc, cur, wr, wc, fr, fq); S.done(cur); }
        if (!has_next) break;
#pragma unroll
        for (int a = 0; a < 2; ++a)
#pragma unroll
            for (int b = 0; b < 2; ++b)
#pragma unroll
                for (int m = 0; m < 4; ++m)
#pragma unroll
                    for (int n = 0; n < 2; ++n) acc[a][b][m][n] = (f32x4){0.f, 0.f, 0.f, 0.f};
        cur = nxt; cA = nA; cB = nB; ++ui;
        if constexpr (ALIGN_EPI) { if (wr == 1) PG8_BAR; }
    }
    PG8_WAIT_V(0);
    if constexpr (!ALIGN_EPI) { if (wr == 0) PG8_BAR; }
    PG8_BAR;
    if constexpr (Epi::AFTER_DRAIN) { E.fused(acc, cur, wr, wc, fr, fq, lds, wid, lane); S.done(cur); }
#undef PG8_SA
#undef PG8_SB
#undef PG8_STAGE
#undef PG8_LDA
#undef PG8_LDB
#undef PG8_MMA
#undef PG8_WAIT_V
#undef PG8_WAIT_L
#undef PG8_BAR
#undef PG8_SCHED
}
}

#ifndef MK_ALIGN
#define MK_ALIGN true
#endif
#ifndef MK_SP2
#define MK_SP2 true
#endif
#ifndef MK_STOP
#define MK_STOP N_PHASES
#endif
#ifndef MK_CHECK
#define MK_CHECK 0
#endif
#ifndef MK_DUPMASK
#define MK_DUPMASK 0
#endif
#ifndef MK_XSYNC
#define MK_XSYNC 0
#endif
#ifndef MK_TPH
#define MK_TPH -1
#endif
#ifndef MK_XBF16
#define MK_XBF16 1
#endif
#ifndef MK_TPH_END
#define MK_TPH_END 5
#endif
#ifndef MK_MULTI
#define MK_MULTI 0
#endif
#define LAS __attribute__((address_space(3)))
typedef unsigned short bf16;
using pg8::f32x4; using pg8::bf16x8; using pg8::u32x4;
typedef unsigned u32x2 __attribute__((ext_vector_type(2)));

constexpr int NT = 16384, DM = 2048, FF = 5632, SEQ = 4096;
constexpr float EPS = 1e-6f;
constexpr size_t MiB = 1u << 20;
constexpr size_t WS_WGU = 2 * MiB, WS_WD = 178 * MiB, WS_WEIN = 266 * MiB, WS_WEOUT = 286 * MiB, WS_WOIN = 294 * MiB, WS_WOOUT = 306 * MiB,
                 WS_WGLU = 314 * MiB, WS_PWT = 316 * MiB, WS_HN = 318 * MiB, WS_MIX = 382 * MiB, WS_F = 446 * MiB, WS_BIG = 510 * MiB, WS_XB = 686 * MiB, WS_END = 750 * MiB;
constexpr size_t BIG_VT = 112 * MiB;
constexpr size_t BIG_VT2 = 64 * MiB, BIG_Y = 96 * MiB, BIG_E = 128 * MiB, BIG_RSTD = 136 * MiB;
constexpr int LDS_BYTES = 147456;
constexpr int N_PHASES = 25;
constexpr int CW_BAR = 4096;

struct Args { const float* in[24]; float* out; unsigned char* ws; int ph_lo, ph_hi;
#if MK_DUPMASK
  int dup_done, pad_;
#endif
};

__device__ __forceinline__ float bf_lo(unsigned x) { return __builtin_bit_cast(float, x << 16); }
__device__ __forceinline__ float bf_hi(unsigned x) { return __builtin_bit_cast(float, x & 0xffff0000u); }
typedef float f32x2_t __attribute__((ext_vector_type(2)));
typedef __bf16 bf16x2_t __attribute__((ext_vector_type(2)));
__device__ __forceinline__ unsigned pk2(float lo, float hi) { const f32x2_t v = {lo, hi}; const bf16x2_t b = __builtin_convertvector(v, bf16x2_t); return __builtin_bit_cast(unsigned, b); }
__device__ __forceinline__ float wave_sum(float v) {
#pragma unroll
    for (int o = 1; o < 64; o <<= 1) v += __shfl_xor(v, o);
    return v;
}
__device__ __forceinline__ f32x4 mfma16(bf16x8 a, bf16x8 b, f32x4 c) { return __builtin_amdgcn_mfma_f32_16x16x32_bf16(a, b, c, 0, 0, 0); }

#define XB_TMO      128
#define XB_XCNT(j)  (256  + 64 * (j))
#define XB_XSUB(j)  (1280 + 64 * (j))
#define XB_XGEN(j)  (2304 + 64 * (j))
#define XB_TOP      3328
#define XB_TOPGEN   3392
#define XCD_BAR_WORDS 3456
#define XB_SPIN_CAP (1u << 18)

__device__ __forceinline__ unsigned xb_ld(unsigned* p)              { return __hip_atomic_load(p, __ATOMIC_RELAXED, __HIP_MEMORY_SCOPE_AGENT); }
__device__ __forceinline__ unsigned xb_add(unsigned* p, unsigned v) { return __hip_atomic_fetch_add(p, v, __ATOMIC_RELAXED, __HIP_MEMORY_SCOPE_AGENT); }
__device__ __forceinline__ unsigned xb_xcc_id() { return (unsigned)__builtin_amdgcn_s_getreg((3 << 11) | 20) & 0xFu; }
#define XB_SPIN(cond, bar) do { unsigned _sp = 0; while (cond) { __builtin_amdgcn_s_sleep(1); \
    if ((++_sp & 255u) == 0u) { if (xb_ld(&(bar)[XB_TMO])) break; if (_sp > XB_SPIN_CAP) { atomicAdd(&(bar)[XB_TMO], 1u); break; } } } } while (0)

struct XcdBarrier {
    unsigned* bar; unsigned x;
    volatile LAS unsigned* st;
};

__device__ __forceinline__ XcdBarrier xcd_barrier_post(unsigned* bar, volatile LAS unsigned* st) {
    XcdBarrier b; b.bar = bar; b.x = xb_xcc_id(); b.st = st;
    if (threadIdx.x == 0) (void)xb_add(&bar[XB_XCNT(b.x)], 1u);
    return b;
}
__device__ __forceinline__ void xcd_barrier_complete(unsigned* bar, unsigned x, unsigned& nloc, unsigned& nx) {
    const unsigned G = gridDim.x * gridDim.y * gridDim.z;
    unsigned sum, cnt, mine, sp = 0u;
    for (;;) {
        sum = 0u; cnt = 0u; mine = 0u;
#pragma unroll
        for (unsigned j = 0; j < 16; ++j) { const unsigned c = xb_ld(&bar[XB_XCNT(j)]); sum += c; cnt += (c > 0u) ? 1u : 0u; mine = (j == x) ? c : mine; }
        if (sum == G) break;
        __builtin_amdgcn_s_sleep(1);
        if ((++sp & 255u) == 0u) { if (xb_ld(&bar[XB_TMO])) break; if (sp > XB_SPIN_CAP) { atomicAdd(&bar[XB_TMO], 1u); break; } }
    }
    nloc = mine > 0u ? mine : 1u; nx = cnt > 0u ? cnt : 1u;
}

__device__ __forceinline__ void xcd_barrier(const XcdBarrier& b) {
    asm volatile("s_waitcnt vmcnt(0)" ::: "memory");
    __syncthreads();
    if (threadIdx.x == 0) {
        unsigned* bar = b.bar;
        __builtin_amdgcn_s_waitcnt(0);
        unsigned nloc = b.st[0], nx = b.st[1];
        if (nloc == 0u) { xcd_barrier_complete(bar, b.x, nloc, nx); b.st[0] = nloc; b.st[1] = nx; }
        const unsigned old = xb_add(&bar[XB_XSUB(b.x)], 1u);
        const unsigned gen = old / nloc;
        if (old + 1u == (gen + 1u) * nloc) {
            __builtin_amdgcn_fence(__ATOMIC_RELEASE, "agent");
            asm volatile("s_waitcnt vmcnt(0)" ::: "memory");
            const unsigned og = xb_add(&bar[XB_TOP], 1u);
            const unsigned tg = og / nx;
            if (og + 1u == (tg + 1u) * nx) xb_add(&bar[XB_TOPGEN], 1u);
            else XB_SPIN(xb_ld(&bar[XB_TOPGEN]) == tg, bar);
            __builtin_amdgcn_fence(__ATOMIC_ACQUIRE, "agent");
            xb_add(&bar[XB_XGEN(b.x)], 1u);
            asm volatile("s_waitcnt vmcnt(0)" ::: "memory");
        } else {
            XB_SPIN(xb_ld(&bar[XB_XGEN(b.x)]) == gen, bar);
            __builtin_amdgcn_fence(__ATOMIC_ACQUIRE, "agent");
            asm volatile("s_waitcnt vmcnt(0)" ::: "memory");
        }
    }
    __syncthreads();
}

__device__ __forceinline__ void transpose_item(const float* W, int K, int N, bf16* WT, int item, LAS float* scr, int lane, int mode) {
    const int nblk = N / 32, kb = item / nblk, nb = item % nblk, k0 = 64 * kb, n0 = 32 * nb;
    int d0 = n0; if (mode) d0 = (n0 >> 7) * 256 + (n0 & 127) + (mode == 2 ? 128 : 0);
    { f32x4 v[8];
#pragma unroll
      for (int i = 0; i < 8; ++i) v[i] = __builtin_nontemporal_load((const f32x4*)(W + (size_t)(k0 + 8 * i + (lane >> 3)) * N + n0 + 4 * (lane & 7)));
#pragma unroll
      for (int i = 0; i < 8; ++i) { LAS float* d = scr + (8 * i + (lane >> 3)) * 33 + 4 * (lane & 7); d[0] = v[i][0]; d[1] = v[i][1]; d[2] = v[i][2]; d[3] = v[i][3]; } }
    asm volatile("s_waitcnt lgkmcnt(0)" ::: "memory");
    const int c = lane & 7;
#pragma unroll
    for (int j = 0; j < 4; ++j) { const int n = (lane >> 3) + 8 * j; const LAS float* s = scr + (8 * c) * 33 + n;
        u32x4 o; o.x = pk2(s[0 * 33], s[1 * 33]); o.y = pk2(s[2 * 33], s[3 * 33]); o.z = pk2(s[4 * 33], s[5 * 33]); o.w = pk2(s[6 * 33], s[7 * 33]);
        *(u32x4*)(WT + (size_t)(d0 + n) * K + k0 + 8 * c) = o; }
    asm volatile("s_waitcnt lgkmcnt(0)" ::: "memory");
}

__device__ __forceinline__ void phase_conv(const Args& a, LAS unsigned char* lds, int gw, int NGW, int wave, int lane) {
    LAS float* scr = (LAS float*)(lds + wave * 16384);
    unsigned char* ws = a.ws;
    constexpr int I_G = 32 * 176, I_D = 88 * 64, I_EIN = 32 * 160, I_SQ = 32 * 64, I_OIN = 32 * 96, I_GLU = 16 * 32, I_P = 2 * 4;
    constexpr int NITEMS = 8 * I_G + 4 * I_D + I_EIN + 2 * I_SQ + I_OIN + I_GLU + 4 * I_P;
    for (int it = gw; it < NITEMS; it += NGW) {
        int r = it;
        if (r < 8 * I_G) { const int m = r / I_G; r -= m * I_G; const int lf = m >> 1, up = m & 1;
            transpose_item((up ? a.in[3] : a.in[2]) + (size_t)lf * DM * FF, DM, FF, (bf16*)(ws + WS_WGU) + (size_t)lf * 11264 * 2048, r, scr, lane, 1 + up); continue; }
        r -= 8 * I_G;
        if (r < 4 * I_D) { const int lf = r / I_D; r -= lf * I_D;
            transpose_item(a.in[4] + (size_t)lf * FF * DM, FF, DM, (bf16*)(ws + WS_WD) + (size_t)lf * 2048 * 5632, r, scr, lane, 0); continue; }
        r -= 4 * I_D;
        if (r < I_EIN) { transpose_item(a.in[5], DM, 5120, (bf16*)(ws + WS_WEIN), r, scr, lane, 0); continue; } r -= I_EIN;
        if (r < I_SQ) { transpose_item(a.in[8], DM, DM, (bf16*)(ws + WS_WEOUT), r, scr, lane, 0); continue; } r -= I_SQ;
        if (r < I_SQ) { transpose_item(a.in[23], DM, DM, (bf16*)(ws + WS_WOOUT), r, scr, lane, 0); continue; } r -= I_SQ;
        if (r < I_OIN) { transpose_item(a.in[9], DM, 3072, (bf16*)(ws + WS_WOIN), r, scr, lane, 0); continue; } r -= I_OIN;
        if (r < I_GLU) { transpose_item(a.in[18], 1024, 1024, (bf16*)(ws + WS_WGLU), r, scr, lane, 0); continue; } r -= I_GLU;
        { const int g = r / I_P; r -= g * I_P; transpose_item(a.in[6] + (size_t)g * 128 * 128, 128, 128, (bf16*)(ws + WS_PWT) + (size_t)g * 128 * 128, r, scr, lane, 0); }
    }
}

__device__ __forceinline__ void unpack8(const u32x4 p, f32x4& lo, f32x4& hi) { lo = (f32x4){bf_lo(p.x), bf_hi(p.x), bf_lo(p.y), bf_hi(p.y)}; hi = (f32x4){bf_lo(p.z), bf_hi(p.z), bf_lo(p.w), bf_hi(p.w)}; }
__device__ __forceinline__ u32x4 pack8(const f32x4 lo, const f32x4 hi) { return (u32x4){pk2(lo[0], lo[1]), pk2(lo[2], lo[3]), pk2(hi[0], hi[1]), pk2(hi[2], hi[3])}; }
__device__ __forceinline__ void phase_row(const float* xsrc, const bf16* xsrc_b, const bf16* Fb, const float* gF, float alpha, float* xdst, bf16* xdst_b, const float* gH, bf16* HN, int gw, int NGW, int lane, unsigned npert) {
    f32x4 gFv[8], gHv[8];
#pragma unroll
    for (int j = 0; j < 4; ++j) { gFv[2 * j] = gF ? ((const f32x4*)gF)[128 * j + 2 * lane] : (f32x4){0.f, 0.f, 0.f, 0.f}; gFv[2 * j + 1] = gF ? ((const f32x4*)gF)[128 * j + 2 * lane + 1] : (f32x4){0.f, 0.f, 0.f, 0.f};
        gHv[2 * j] = gH ? ((const f32x4*)gH)[128 * j + 2 * lane] : (f32x4){0.f, 0.f, 0.f, 0.f}; gHv[2 * j + 1] = gH ? ((const f32x4*)gH)[128 * j + 2 * lane + 1] : (f32x4){0.f, 0.f, 0.f, 0.f}; }
    for (int m = gw; m < NT; m += NGW) {
        f32x4 v[8];
        if (xsrc_b) { const u32x4* xr = (const u32x4*)(xsrc_b + (size_t)m * DM) + lane;
#pragma unroll
            for (int j = 0; j < 4; ++j) unpack8(xr[64 * j], v[2 * j], v[2 * j + 1]); }
        else { const f32x4* xr = (const f32x4*)(xsrc + (size_t)m * DM) + 2 * lane;
#pragma unroll
            for (int j = 0; j < 4; ++j) { v[2 * j] = xr[128 * j]; v[2 * j + 1] = xr[128 * j + 1]; } }
        if (Fb) {
            const u32x4* fp = (const u32x4*)(Fb + (size_t)m * DM) + lane;
            f32x4 f[8]; float s = 0.f;
#pragma unroll
            for (int j = 0; j < 4; ++j) unpack8(fp[64 * j], f[2 * j], f[2 * j + 1]);
#pragma unroll
            for (int j = 0; j < 8; ++j) s += (f[j][0] * f[j][0] + f[j][1] * f[j][1]) + (f[j][2] * f[j][2] + f[j][3] * f[j][3]);
            const float rs = alpha / sqrtf(wave_sum(s) * (1.f / DM) + EPS);
#pragma unroll
            for (int j = 0; j < 8; ++j) v[j] = v[j] + f[j] * gFv[j] * rs;
#if MK_TPH != -1
            if (!gH) {
#pragma unroll
                for (int j = 0; j < 8; ++j)
#pragma unroll
                    for (int i = 0; i < 4; ++i) if ((unsigned)(m * DM + (64 * (j >> 1) + lane) * 8 + (j & 1) * 4 + i) < npert) v[j][i] += 0.05f; }
#endif
            if (xdst_b) { u32x4* xo = (u32x4*)(xdst_b + (size_t)m * DM) + lane;
#pragma unroll
                for (int j = 0; j < 4; ++j) __builtin_nontemporal_store(pack8(v[2 * j], v[2 * j + 1]), &xo[64 * j]); }
            else { f32x4* xo = (f32x4*)(xdst + (size_t)m * DM) + 2 * lane;
#pragma unroll
                for (int j = 0; j < 4; ++j) { xo[128 * j] = v[2 * j]; xo[128 * j + 1] = v[2 * j + 1]; } }
        }
        if (gH) {
            float s = 0.f;
#pragma unroll
            for (int j = 0; j < 8; ++j) s += (v[j][0] * v[j][0] + v[j][1] * v[j][1]) + (v[j][2] * v[j][2] + v[j][3] * v[j][3]);
            const float rs = 1.f / sqrtf(wave_sum(s) * (1.f / DM) + EPS);
            u32x4* ho = (u32x4*)(HN + (size_t)m * DM) + lane;
#pragma unroll
            for (int j = 0; j < 4; ++j) __builtin_nontemporal_store(pack8(v[2 * j] * gHv[2 * j] * rs, v[2 * j + 1] * gHv[2 * j + 1] * rs), &ho[64 * j]);
        }
    }
}

__device__ __forceinline__ void pool_item(const Args& a, const bf16* P, const bf16* PWT, bf16* MIX, int item, int wave, int lane) {
    const int fr = lane & 15, fq = lane >> 4;
    const int g = (item < 256) ? (item & 3) : 3 - (item & 3), tt = item >> 2;
    const int tok = tt * 128 + wave * 16 + fr, tpos = tok & (SEQ - 1), Wn = 2 << g;
    const int nwin = (tpos + 1 < Wn) ? tpos + 1 : Wn;
    const float inv = 1.0f / (float)nwin;
    bf16x8 af[4];
#pragma unroll
    for (int kk = 0; kk < 4; ++kk) {
        const bf16* p = P + (size_t)tok * 3584 + g * 128 + kk * 32 + fq * 8;
        float s[8];
#pragma unroll
        for (int e = 0; e < 8; ++e) s[e] = 0.f;
        const u32x4 own = *(const u32x4*)p;
        u32x4 rr[15];
#pragma unroll
        for (int d = 1; d < 16; ++d) if (d < Wn) { const int dd = (d <= tpos) ? d : 0; rr[d - 1] = *(const u32x4*)(p - (size_t)dd * 3584); }
#pragma unroll
        for (int e = 0; e < 4; ++e) { s[2 * e] = bf_lo(own[e]); s[2 * e + 1] = bf_hi(own[e]); }
#pragma unroll
        for (int d = 1; d < 16; ++d) if (d < Wn) { const float m = (d <= tpos) ? 1.f : 0.f;
#pragma unroll
            for (int e = 0; e < 4; ++e) { s[2 * e] += m * bf_lo(rr[d - 1][e]); s[2 * e + 1] += m * bf_hi(rr[d - 1][e]); } }
        u32x4 o;
#pragma unroll
        for (int e = 0; e < 4; ++e) o[e] = pk2(s[2 * e] * inv - bf_lo(own[e]), s[2 * e + 1] * inv - bf_hi(own[e]));
        af[kk] = __builtin_bit_cast(bf16x8, o);
    }
    const float* scale = a.in[7];
#pragma unroll
    for (int nt = 0; nt < 8; ++nt) {
        f32x4 acc = (f32x4){0.f, 0.f, 0.f, 0.f};
#pragma unroll
        for (int kk = 0; kk < 4; ++kk) { const bf16x8 wf = *(const bf16x8*)(PWT + ((size_t)(g * 128 + nt * 16 + fr)) * 128 + kk * 32 + fq * 8); acc = mfma16(wf, af[kk], acc); }
        const int c = g * 128 + nt * 16 + 4 * fq; const f32x4 sc = *(const f32x4*)(scale + c);
        *(u32x2*)(MIX + (size_t)tok * DM + c) = (u32x2){pk2(acc[0] * sc[0], acc[1] * sc[1]), pk2(acc[2] * sc[2], acc[3] * sc[3])};
    }
}

constexpr int AK_PITCH = 272, AV_PITCH = 80, AK_BYTES = 32 * AK_PITCH, AV_BYTES = 128 * AV_PITCH, ABUF = AK_BYTES + AV_BYTES, AFLAG_OFF = 2 * ABUF;
__device__ __forceinline__ void attn_wg_item(const bf16* P, const bf16* VT, bf16* MIX, LAS unsigned char* lds, int item, int wave, int lane, int tid) {
    const int fr = lane & 15, fq = lane >> 4;
    const int qblk = item & 31, bh = item >> 5, h = bh % 12, b = bh / 12;
    const int q0b = qblk * 128, q0 = q0b + wave * 16, t = q0 + fr; const size_t tokb = (size_t)b * SEQ;
    bf16x8 qf[4];
#pragma unroll
    for (int kk = 0; kk < 4; ++kk) qf[kk] = *(const bf16x8*)(P + (tokb + t) * 3584 + 512 + h * 128 + kk * 32 + fq * 8);
    f32x4 o[8];
#pragma unroll
    for (int dt = 0; dt < 8; ++dt) o[dt] = (f32x4){0.f, 0.f, 0.f, 0.f};
    float R = 0.f; bool done = false;
    const int krow = tid >> 4, kch = tid & 15, vrow = tid >> 2, vch = tid & 3;
    const bf16* kg = P + (tokb + krow) * 3584 + 2048 + h * 128 + kch * 8;
    const bf16* vg = VT + (size_t)(h * 128 + vrow) * NT + tokb + vch * 8;
    int kt = (q0b + 127) >> 5;
    u32x4 kr = *(const u32x4*)(kg + (size_t)(kt * 32) * 3584), vr = *(const u32x4*)(vg + kt * 32);
    for (;;) {
        LAS unsigned char* buf = lds + (kt & 1) * ABUF;
        volatile LAS unsigned* flg = (volatile LAS unsigned*)(lds + AFLAG_OFF + (kt & 1) * 64);
        *(LAS u32x4*)(buf + krow * AK_PITCH + kch * 16) = kr;
        *(LAS u32x4*)(buf + AK_BYTES + vrow * AV_PITCH + vch * 16) = vr;
        if (lane == 0) flg[wave] = done ? 1u : 0u;
        if (kt > 0) { kr = *(const u32x4*)(kg + (size_t)((kt - 1) * 32) * 3584); vr = *(const u32x4*)(vg + (kt - 1) * 32); }
        __syncthreads();
        unsigned alld = 1u;
#pragma unroll
        for (int w = 0; w < 8; ++w) alld &= flg[w];
        if (alld) break;
        const int s0 = kt * 32;
        if (!done && s0 <= q0 + 14) {
            f32x4 z[2]; z[0] = (f32x4){0.f, 0.f, 0.f, 0.f}; z[1] = z[0];
#pragma unroll
            for (int kk = 0; kk < 4; ++kk) { const bf16x8 k0 = *(const LAS bf16x8*)(buf + fr * AK_PITCH + kk * 64 + fq * 16), k1 = *(const LAS bf16x8*)(buf + (16 + fr) * AK_PITCH + kk * 64 + fq * 16);
                z[0] = mfma16(k0, qf[kk], z[0]); z[1] = mfma16(k1, qf[kk], z[1]); }
            float lsp[2][4], lk[2][4], tot[2];
#pragma unroll
            for (int sub = 0; sub < 2; ++sub) { tot[sub] = 0.f;
#pragma unroll
                for (int r = 0; r < 4; ++r) { const int key = s0 + sub * 16 + 4 * fq + r; const bool valid = key < t;
                    const float zz = z[sub][r] * 0.08838834764831845f;
                    const float l1p = 0.6931471805599453f * __builtin_amdgcn_logf(1.0f + __expf(-fabsf(zz)));
                    lsp[sub][r] = valid ? (fminf(zz, 0.f) - l1p) : -1e30f;
                    lk[sub][r] = valid ? -(fmaxf(zz, 0.f) + l1p) : 0.f;
                    tot[sub] += lk[sub][r]; } }
            float G[2], TT[2];
#pragma unroll
            for (int sub = 0; sub < 2; ++sub) {
                const float a1 = __shfl_down(tot[sub], 16), a2 = __shfl_down(tot[sub], 32), a3 = __shfl_down(tot[sub], 48);
                G[sub] = (fq < 3 ? a1 : 0.f) + (fq < 2 ? a2 : 0.f) + (fq < 1 ? a3 : 0.f);
                const float t1 = tot[sub] + __shfl_xor(tot[sub], 16); TT[sub] = t1 + __shfl_xor(t1, 32);
            }
            float w[2][4];
#pragma unroll
            for (int sub = 0; sub < 2; ++sub) { float later = R + G[sub] + (sub == 0 ? TT[1] : 0.f);
#pragma unroll
                for (int r = 3; r >= 0; --r) { w[sub][r] = __expf(lsp[sub][r] + later); later += lk[sub][r]; } }
            u32x4 wp; wp.x = pk2(w[0][0], w[0][1]); wp.y = pk2(w[0][2], w[0][3]); wp.z = pk2(w[1][0], w[1][1]); wp.w = pk2(w[1][2], w[1][3]);
            const bf16x8 wf = __builtin_bit_cast(bf16x8, wp);
            const LAS unsigned char* vb = buf + AK_BYTES + fr * AV_PITCH + fq * 8;
#pragma unroll
            for (int dt = 0; dt < 8; ++dt) { const u32x2 v0 = *(const LAS u32x2*)(vb + dt * 16 * AV_PITCH), v1 = *(const LAS u32x2*)(vb + dt * 16 * AV_PITCH + 32);
                const u32x4 vv = (u32x4){v0.x, v0.y, v1.x, v1.y};
                o[dt] = mfma16(__builtin_bit_cast(bf16x8, vv), wf, o[dt]); }
            R += TT[0] + TT[1];
            if (__all(R < -110.f)) done = true;
        }
        if (kt == 0) break;
        --kt;
    }
    __syncthreads();
    bf16* op = MIX + (tokb + t) * DM + 512 + h * 128 + 4 * fq;
#pragma unroll
    for (int dt = 0; dt < 8; ++dt) *(u32x2*)(op + dt * 16) = (u32x2){pk2(o[dt][0], o[dt][1]), pk2(o[dt][2], o[dt][3])};
}

__device__ __forceinline__ void sincos_f(float x, float& s, float& c) {
    const float k = rintf(x * 0.6366197723675814f);
    float r = fmaf(-k, 1.5707962513e+00f, x); r = fmaf(-k, 7.5497894159e-08f, r);
    const float r2 = r * r;
    const float sp = r + r * r2 * (-1.6666654611e-1f + r2 * (8.3321608736e-3f + r2 * (-1.9515295891e-4f)));
    const float cp = 1.0f - 0.5f * r2 + r2 * r2 * (4.166664568298827e-2f + r2 * (-1.388731625493765e-3f + r2 * 2.443315711809948e-5f));
    const int q = ((int)k) & 3;
    s = (q == 0) ? sp : (q == 1) ? cp : (q == 2) ? -sp : -cp;
    c = (q == 0) ? cp : (q == 1) ? -sp : (q == 2) ? -cp : sp;
}

typedef float f2v __attribute__((ext_vector_type(2)));
constexpr int SSM_ROWB = 272, SSM_TILEB = 64 * SSM_ROWB;
struct SsmOps { bf16x8 af[8]; bf16x8 cf[4]; f32x4 dsk; float lr, li, pr, pi; };
template <bool OUT>
__device__ __forceinline__ SsmOps ssm_setup(const Args& a, LAS unsigned char* lds, int wave, int g, int lane) {
    SsmOps o;
    const int n = lane, fr = lane & 15, fq = lane >> 4;
    const float dt = expf(a.in[12][g]);
    const float are = a.in[10][g * 64 + n], aim = a.in[11][g * 64 + n];
    const float mag = expf(are * dt); float sn, cs; sincos_f(aim * dt, sn, cs);
    const float lr = mag * cs, li = mag * sn;
    const float den = are * are + aim * aim, nr = lr - 1.0f;
    const float fre = (nr * are + li * aim) / den, fim = (li * are - nr * aim) / den;
    f2v bb[16];
    { const f32x4* br = (const f32x4*)(a.in[13] + (size_t)(g * 64 + n) * 16); const f32x4* bi = (const f32x4*)(a.in[14] + (size_t)(g * 64 + n) * 16);
#pragma unroll
      for (int q = 0; q < 4; ++q) { const f32x4 x = br[q], y = bi[q];
#pragma unroll
          for (int i = 0; i < 4; ++i) bb[4 * q + i] = (f2v){fre * x[i] - fim * y[i], fre * y[i] + fim * x[i]}; } }
    LAS unsigned char* tile = lds + wave * SSM_TILEB;
    { u32x4 w;
      w = (u32x4){pk2(bb[0].x, bb[1].x), pk2(bb[2].x, bb[3].x), pk2(bb[4].x, bb[5].x), pk2(bb[6].x, bb[7].x)};         *(LAS u32x4*)(tile + (2 * n) * 32) = w;
      w = (u32x4){pk2(bb[8].x, bb[9].x), pk2(bb[10].x, bb[11].x), pk2(bb[12].x, bb[13].x), pk2(bb[14].x, bb[15].x)};   *(LAS u32x4*)(tile + (2 * n) * 32 + 16) = w;
      w = (u32x4){pk2(bb[0].y, bb[1].y), pk2(bb[2].y, bb[3].y), pk2(bb[4].y, bb[5].y), pk2(bb[6].y, bb[7].y)};         *(LAS u32x4*)(tile + (2 * n + 1) * 32) = w;
      w = (u32x4){pk2(bb[8].y, bb[9].y), pk2(bb[10].y, bb[11].y), pk2(bb[12].y, bb[13].y), pk2(bb[14].y, bb[15].y)};   *(LAS u32x4*)(tile + (2 * n + 1) * 32 + 16) = w; }
    const bf16x8 zero8 = (bf16x8){0, 0, 0, 0, 0, 0, 0, 0};
#pragma unroll
    for (int nt = 0; nt < 8; ++nt) o.af[nt] = (fq < 2) ? *(const LAS bf16x8*)(tile + (nt * 16 + fr) * 32 + fq * 16) : zero8;
    asm volatile("s_waitcnt lgkmcnt(0)" ::: "memory");
    float pr = lr, pi = li;
#pragma unroll
    for (int q = 0; q < 6; ++q) { const float tr = pr * pr - pi * pi; pi = 2.f * pr * pi; pr = tr; }
    o.lr = lr; o.li = li; o.pr = pr; o.pi = pi;
    if (OUT) {
#pragma unroll
        for (int kk = 0; kk < 4; ++kk) { const size_t off = (size_t)(g * 16 + fr) * 64 + kk * 16 + 4 * fq;
            const f32x4 cr = *(const f32x4*)(a.in[15] + off), ci = *(const f32x4*)(a.in[16] + off);
            const u32x4 w = (u32x4){pk2(cr[0], -ci[0]), pk2(cr[1], -ci[1]), pk2(cr[2], -ci[2]), pk2(cr[3], -ci[3])};
            o.cf[kk] = __builtin_bit_cast(bf16x8, w); }
        o.dsk = *(const f32x4*)(a.in[17] + g * 16 + 4 * fq);
    } else { o.dsk = (f32x4){0.f, 0.f, 0.f, 0.f};
#pragma unroll
        for (int kk = 0; kk < 4; ++kk) o.cf[kk] = (bf16x8){0, 0, 0, 0, 0, 0, 0, 0}; }
    return o;
}

template <bool OUT>
__device__ __forceinline__ void ssm_item(const Args& a, const bf16* Podd, float2* E, bf16* Y, LAS unsigned char* lds, int item, int wave, int lane, const SsmOps o) {
    const int g = item & 63, c = (item >> 6) & 63, b = item >> 12, n = lane;
    const float lr = o.lr, li = o.li;
    const size_t tok0 = (size_t)b * SEQ + c * 64;
    const int fr = lane & 15, fq = lane >> 4;
    LAS unsigned char* tile = lds + wave * SSM_TILEB;
    LAS unsigned* Sw = (LAS unsigned*)tile;
    bf16x8 ub[4];
    const bf16x8 zero8 = (bf16x8){0, 0, 0, 0, 0, 0, 0, 0};
#pragma unroll
    for (int tt = 0; tt < 4; ++tt) ub[tt] = (fq < 2) ? *(const bf16x8*)(Podd + (tok0 + tt * 16 + fr) * 2048 + g * 16 + 8 * fq) : zero8;
    float sr = 0.f, si = 0.f;
    if (OUT) {
        const float pr = o.pr, pi = o.pi;
        const float2* Ep = E + ((size_t)(b * 64) * 64 + g) * 64 + n;
        for (int c0 = 0; c0 < c; c0 += 32) {
            float2 e[32];
#pragma unroll
            for (int k = 0; k < 32; ++k) { const int cc = (c0 + k < c) ? c0 + k : c - 1; e[k] = Ep[(size_t)cc * 4096]; }
#pragma unroll
            for (int k = 0; k < 32; ++k) if (c0 + k < c) { const float tr = pr * sr - pi * si + e[k].x; si = pr * si + pi * sr + e[k].y; sr = tr; }
        }
    }
#pragma unroll
    for (int tt = 0; tt < 4; ++tt)
#pragma unroll
        for (int nt = 0; nt < 8; ++nt) { const f32x4 d = mfma16(o.af[nt], ub[tt], (f32x4){0.f, 0.f, 0.f, 0.f});
            *(LAS u32x2*)(tile + (tt * 16 + fr) * SSM_ROWB + (nt * 16 + 4 * fq) * 2) = (u32x2){pk2(d[0], d[1]), pk2(d[2], d[3])}; }
    f2v s = (f2v){sr, si};
    const f2v lam_a = (f2v){lr, lr}, lam_b = (f2v){-li, li};
    for (int t0 = 0; t0 < 64; t0 += 8) {
        unsigned bw[8];
#pragma unroll
        for (int k = 0; k < 8; ++k) bw[k] = Sw[(t0 + k) * (SSM_ROWB / 4) + n];
#pragma unroll
        for (int k = 0; k < 8; ++k) { const f2v bu = (f2v){bf_lo(bw[k]), bf_hi(bw[k])};
            s = lam_a * s + (lam_b * (f2v){s.y, s.x} + bu);
            if (OUT) Sw[(t0 + k) * (SSM_ROWB / 4) + n] = pk2(s.x, s.y); }
    }
    if (!OUT) { E[((size_t)(b * 64 + c) * 64 + g) * 64 + n] = make_float2(s.x, s.y); }
    else {
        const f32x4 dsk = o.dsk;
        const LAS unsigned char* Sr = lds + wave * SSM_TILEB + fr * SSM_ROWB + fq * 16;
#pragma unroll
        for (int tt = 0; tt < 4; ++tt) {
            f32x4 acc = (f32x4){0.f, 0.f, 0.f, 0.f};
#pragma unroll
            for (int kk = 0; kk < 4; ++kk) { const bf16x8 sf = *(const LAS bf16x8*)(Sr + tt * 16 * SSM_ROWB + kk * 64); acc = mfma16(o.cf[kk], sf, acc); }
            const size_t tok = tok0 + tt * 16 + fr;
            const u32x2 uu = *(const u32x2*)(Podd + tok * 2048 + g * 16 + 4 * fq);
            const float y0 = pg8::gelu_f(acc[0] + dsk[0] * bf_lo(uu.x)), y1 = pg8::gelu_f(acc[1] + dsk[1] * bf_hi(uu.x));
            const float y2 = pg8::gelu_f(acc[2] + dsk[2] * bf_lo(uu.y)), y3 = pg8::gelu_f(acc[3] + dsk[3] * bf_hi(uu.y));
            *(u32x2*)(Y + tok * 1024 + g * 16 + 4 * fq) = (u32x2){pk2(y0, y1), pk2(y2, y3)};
        }
    }
}

__device__ __forceinline__ void rowstat_item(const bf16* VT2, float* RSTD, LAS float* red, int item, int tid) {
    const int tg = tid & 7, cs = tid >> 3;
    const bf16* p = VT2 + (size_t)(cs * 16) * NT + item * 64 + tg * 8;
    u32x4 r[16];
#pragma unroll
    for (int c = 0; c < 16; ++c) r[c] = *(const u32x4*)(p + (size_t)c * NT);
    float s[8];
#pragma unroll
    for (int e = 0; e < 8; ++e) s[e] = 0.f;
#pragma unroll
    for (int c = 0; c < 16; ++c)
#pragma unroll
        for (int e = 0; e < 4; ++e) { const float lo = bf_lo(r[c][e]), hi = bf_hi(r[c][e]); s[2 * e] = fmaf(lo, lo, s[2 * e]); s[2 * e + 1] = fmaf(hi, hi, s[2 * e + 1]); }
#pragma unroll
    for (int e = 0; e < 8; ++e) red[cs * 64 + tg * 8 + e] = s[e];
    __syncthreads();
    if (tid < 64) { float tsum = 0.f;
#pragma unroll 8
        for (int w = 0; w < 64; ++w) tsum += red[w * 64 + tid];
        RSTD[item * 64 + tid] = 1.f / sqrtf(tsum * (1.f / 1024.f) + EPS); }
    __syncthreads();
}
__device__ __forceinline__ void sgu_item(const Args& a, const bf16* Podd, const bf16* VT2, const float* RSTD, bf16* MIX, int item, int wave  , int lane) {
    const int fr = lane & 15, fq = lane >> 4;
    const int h = item & 7, nb = item >> 3, tok0 = nb * 128, trow = wave * 16 + fr;
    f32x4 acc[8];
#pragma unroll
    for (int dt = 0; dt < 8; ++dt) acc[dt] = (f32x4){0.f, 0.f, 0.f, 0.f};
    const int nk = (wave * 16 + 15) / 32 + 1;
    const float* sw = a.in[21] + ((size_t)h * 128 + trow) * 128 + fq * 8;
    const float* rp = RSTD + tok0 + fq * 8;
    const bf16* vp = VT2 + (size_t)(h * 128 + fr) * NT + tok0 + fq * 8;
    const float bs = a.in[22][h * 128 + trow];
    const size_t tok = (size_t)tok0 + trow;
    f32x4 gn[8]; u32x2 uu[8];
#pragma unroll
    for (int dt = 0; dt < 8; ++dt) { const int d = h * 128 + dt * 16 + 4 * fq; gn[dt] = *(const f32x4*)(a.in[20] + d); uu[dt] = *(const u32x2*)(Podd + tok * 2048 + 1024 + d); }
    f32x4 w0 = *(const f32x4*)(sw), w1 = *(const f32x4*)(sw + 4), r0 = *(const f32x4*)(rp), r1 = *(const f32x4*)(rp + 4);
    bf16x8 vf[8];
#pragma unroll
    for (int dt = 0; dt < 8; ++dt) vf[dt] = *(const bf16x8*)(vp + (size_t)dt * 16 * NT);
    for (int kk = 0; kk < nk; ++kk) {
        const int kn = (kk + 1 < nk) ? kk + 1 : kk;
        const f32x4 nw0 = *(const f32x4*)(sw + kn * 32), nw1 = *(const f32x4*)(sw + kn * 32 + 4), nr0 = *(const f32x4*)(rp + kn * 32), nr1 = *(const f32x4*)(rp + kn * 32 + 4);
        bf16x8 nvf[8];
#pragma unroll
        for (int dt = 0; dt < 8; ++dt) nvf[dt] = *(const bf16x8*)(vp + kn * 32 + (size_t)dt * 16 * NT);
        float wv[8];
#pragma unroll
        for (int e = 0; e < 4; ++e) { const int s = kk * 32 + fq * 8 + e; wv[e] = (s <= trow) ? w0[e] * r0[e] : 0.f; wv[4 + e] = (s + 4 <= trow) ? w1[e] * r1[e] : 0.f; }
        u32x4 wp; wp.x = pk2(wv[0], wv[1]); wp.y = pk2(wv[2], wv[3]); wp.z = pk2(wv[4], wv[5]); wp.w = pk2(wv[6], wv[7]);
        const bf16x8 wf = __builtin_bit_cast(bf16x8, wp);
#pragma unroll
        for (int dt = 0; dt < 8; ++dt) acc[dt] = mfma16(vf[dt], wf, acc[dt]);
        w0 = nw0; w1 = nw1; r0 = nr0; r1 = nr1;
#pragma unroll
        for (int dt = 0; dt < 8; ++dt) vf[dt] = nvf[dt];
    }
#pragma unroll
    for (int dt = 0; dt < 8; ++dt) { const int d = h * 128 + dt * 16 + 4 * fq;
        const float o0 = bf_lo(uu[dt].x) * (gn[dt][0] * acc[dt][0] + bs), o1 = bf_hi(uu[dt].x) * (gn[dt][1] * acc[dt][1] + bs);
        const float o2 = bf_lo(uu[dt].y) * (gn[dt][2] * acc[dt][2] + bs), o3 = bf_hi(uu[dt].y) * (gn[dt][3] * acc[dt][3] + bs);
        *(u32x2*)(MIX + tok * DM + 1024 + d) = (u32x2){pk2(o0, o1), pk2(o2, o3)}; }
}

__global__ void __launch_bounds__(512, 2) fwd(Args a) {
    extern __shared__ __attribute__((aligned(16))) unsigned char lds_raw[];
    LAS unsigned char* lds = (LAS unsigned char*)lds_raw;
    cg::grid_group grid = cg::this_grid();
    const int G = gridDim.x, bx = blockIdx.x, NGW = G * 8;
    unsigned char* ws = a.ws;
    bf16* const HN = (bf16*)(ws + WS_HN); bf16* const MIX = (bf16*)(ws + WS_MIX); bf16* const Fb = (bf16*)(ws + WS_F); bf16* const BIG = (bf16*)(ws + WS_BIG);
    bf16* const VT = (bf16*)(ws + WS_BIG + BIG_VT); bf16* const VT2 = (bf16*)(ws + WS_BIG + BIG_VT2); bf16* const Yb = (bf16*)(ws + WS_BIG + BIG_Y);
    float2* const Eb = (float2*)(ws + WS_BIG + BIG_E); float* const RSTD = (float*)(ws + WS_BIG + BIG_RSTD);
    const float* normg = a.in[1];
    volatile LAS unsigned* MISC = (volatile LAS unsigned*)(lds + LDS_BYTES - 64);
    if (threadIdx.x < 16) MISC[threadIdx.x] = 0u;
    __syncthreads();
    XcdBarrier xbar; xbar.bar = (unsigned*)ws + CW_BAR; xbar.x = 0; xbar.st = nullptr;
    if (a.ph_hi - a.ph_lo > 1) xbar = xcd_barrier_post((unsigned*)ws + CW_BAR, MISC);

    unsigned long long tph0 = 0;
    for (int ph = a.ph_lo; ph < a.ph_hi; ++ph) {
        bool did = true;
#if MK_TPH >= 0
        if (ph == MK_TPH && bx == 0 && threadIdx.x == 0) tph0 = __builtin_amdgcn_s_memrealtime();
#endif
        int tid_ = threadIdx.x; asm volatile("" : "+v"(tid_));
        const int lane = tid_ & 63, wave = __builtin_amdgcn_readfirstlane(tid_ >> 6), gw = bx * 8 + wave;
        if (ph == 0) {
#ifndef NO_CONV
            phase_conv(a, lds, gw, NGW, wave, lane);
#endif
            phase_row(a.in[0], nullptr, nullptr, nullptr, 0.f, nullptr, nullptr, normg, HN, gw, NGW, lane, 0u);
        } else {
            const int i = (ph - 1) / 12, s = (ph - 1) % 12;
            const float* ng = normg + (size_t)i * 6 * DM;
            if (s == 0 || s == 9) {
                const int lf = i * 2 + (s == 9);
                pg8::Gemm g{HN, (const bf16*)(ws + WS_WGU) + (size_t)lf * 11264 * 2048, NT, 11264, DM}; pg8::StaticOrder S; S.init(NT, 11264, G, bx);
                pg8::EpiSwiglu E{BIG, FF};
#ifndef NO_G1
                pg8::gemm_phase<pg8::EpiSwiglu, pg8::StaticOrder, MK_ALIGN, MK_SP2>(lds, g, S, E);
#endif
            } else if (s == 1 || s == 10 || s == 7) {
                const int lf = i * 2 + (s == 10);
                const bf16* A = (s == 7) ? MIX : BIG; const int K = (s == 7) ? DM : FF;
                const bf16* Bt = (s == 7) ? (const bf16*)(ws + (i == 0 ? WS_WEOUT : WS_WOOUT)) : (const bf16*)(ws + WS_WD) + (size_t)lf * 2048 * 5632;
                pg8::Gemm g{A, Bt, NT, DM, K}; pg8::StaticOrder S; S.init(NT, DM, G, bx);
                pg8::EpiBf16<0> E{Fb, DM, nullptr, 0, 0, 1.f};
#ifndef NO_G2
                pg8::gemm_phase<pg8::EpiBf16<0>, pg8::StaticOrder, MK_ALIGN, MK_SP2>(lds, g, S, E);
#endif
            } else if (s == 2 || s == 8 || s == 11) {
                const int kf = (s == 2) ? 1 : (s == 8) ? 3 : 5;
                const float* gH = (s == 11) ? (i == 0 ? normg + 6 * DM : nullptr) : ng + (size_t)(kf + 1) * DM;
                unsigned npert = 0u;
#if MK_TPH != -1
                npert = (MK_TPH == -2) ? (1u << 20) : ((const volatile unsigned*)ws)[2048];
#endif
#if MK_XBF16
                bf16* const XB = (bf16*)(ws + WS_XB);
                phase_row(a.in[0], (ph == 3) ? nullptr : XB, Fb, ng + (size_t)kf * DM, (s == 8) ? 1.0f : 0.5f, a.out, (ph == N_PHASES - 1) ? nullptr : XB, gH, HN, gw, NGW, lane, npert);
#else
                phase_row((ph == 3) ? a.in[0] : a.out, nullptr, Fb, ng + (size_t)kf * DM, (s == 8) ? 1.0f : 0.5f, a.out, nullptr, gH, HN, gw, NGW, lane, npert);
#endif
            } else if (s == 3) {
                const int N = (i == 0) ? 5120 : 3072;
                pg8::Gemm g{HN, (const bf16*)(ws + (i == 0 ? WS_WEIN : WS_WOIN)), NT, N, DM}; pg8::StaticOrder S; S.init(NT, N, G, bx);
                pg8::EpiIn E{BIG, (i == 0) ? 3584 : 2048, (i == 0) ? VT : VT2, NT, (i == 0) ? 3584 : 2048, (i == 0) ? (1 << 30) : 1024};
#ifndef NO_G3
                pg8::gemm_phase<pg8::EpiIn, pg8::StaticOrder, MK_ALIGN, MK_SP2>(lds, g, S, E);
#endif
            } else if (s == 4) {
                if (i == 0) {
#ifndef NO_POOL
                    for (int it = bx; it < 512; it += G) pool_item(a, BIG, (const bf16*)(ws + WS_PWT), MIX, it, wave, lane);
                    for (int it = bx; it < 4 * 12 * 32; it += G) attn_wg_item(BIG, VT, MIX, lds, it, wave, lane, tid_);
#endif
                } else {
#ifndef NO_SSM
                    for (int it = bx; it < 256; it += G) rowstat_item(VT2, RSTD, (LAS float*)lds, it, tid_);
                    if ((NGW & 63) == 0) { const SsmOps ops = ssm_setup<false>(a, lds, wave, gw & 63, lane);
                      for (int it = gw; it < 4 * 64 * 64; it += NGW) ssm_item<false>(a, BIG, Eb, Yb, lds, it, wave, lane, ops); }
                    else for (int it = gw; it < 4 * 64 * 64; it += NGW) ssm_item<false>(a, BIG, Eb, Yb, lds, it, wave, lane, ssm_setup<false>(a, lds, wave, it & 63, lane));
#endif
                }
            } else if (s == 5) {
                if (i == 1) {
#ifndef NO_SSM3
#if MK_TPH == 100
                    unsigned long long tq0 = __builtin_amdgcn_s_memrealtime();
#endif
                    for (int it = bx; it < 512; it += G) { sgu_item(a, BIG, VT2, RSTD, MIX, 2 * it, wave, lane); sgu_item(a, BIG, VT2, RSTD, MIX, 2 * it + 1, 7 - wave, lane); }
#if MK_TPH == 100
                    __syncthreads(); if (bx == 0 && threadIdx.x == 0) ((unsigned*)ws)[2048] = (unsigned)((__builtin_amdgcn_s_memrealtime() - tq0) * 16ull);
#endif
                    if ((NGW & 63) == 0) { const SsmOps ops = ssm_setup<true>(a, lds, wave, gw & 63, lane);
                      for (int it = gw; it < 4 * 64 * 64; it += NGW) ssm_item<true>(a, BIG, Eb, Yb, lds, it, wave, lane, ops); }
                    else for (int it = gw; it < 4 * 64 * 64; it += NGW) ssm_item<true>(a, BIG, Eb, Yb, lds, it, wave, lane, ssm_setup<true>(a, lds, wave, it & 63, lane));
#endif
                } else did = false;
            } else {
                if (i == 1) {
                    pg8::Gemm g{Yb, (const bf16*)(ws + WS_WGLU), NT, 1024, 1024}; pg8::StaticOrder S; S.init(NT, 1024, G, bx);
                    pg8::EpiGlu E{Yb, 1024, a.in[19], MIX, DM};
#ifndef NO_G4
                    pg8::gemm_phase<pg8::EpiGlu, pg8::StaticOrder, MK_ALIGN, MK_SP2>(lds, g, S, E);
#endif
                } else did = false;
            }
        }
        if (did && ph + 1 < a.ph_hi) { if (a.ph_hi > N_PHASES) grid.sync(); else xcd_barrier(xbar); }
#if MK_TPH >= 0
        if (ph == MK_TPH_END && bx == 0 && threadIdx.x == 0) { ((unsigned*)ws)[2048] = (unsigned)((__builtin_amdgcn_s_memrealtime() - tph0) * 16ull); }
#endif
#if MK_XSYNC
        if (ph >= 1 && ph <= 5) { for (int q = 0; q < 4; ++q) grid.sync(); }
#endif
#if MK_DUPMASK
        if (!(a.dup_done) && ((MK_DUPMASK >> ph) & 1)) { a.dup_done = 1; --ph; } else a.dup_done = 0;
#endif
    }
}


#if MK_CHECK
__device__ __forceinline__ float bfv(const bf16* p, size_t i) { return bf_lo((unsigned)p[i]); }
__device__ __forceinline__ void chk_flag(unsigned* flags, int bit, float fast, float ref) { if (!(fabsf(fast - ref) <= 0.03f * fabsf(ref) + 0.03f)) atomicOr(flags, 1u << bit); }
__global__ void chk(Args a, int which) {
    unsigned char* ws = a.ws; unsigned* flags = (unsigned*)ws;
    const bf16* HN = (const bf16*)(ws + WS_HN); const bf16* MIX = (const bf16*)(ws + WS_MIX); const bf16* BIG = (const bf16*)(ws + WS_BIG);
    const bf16* VT = (const bf16*)(ws + WS_BIG + BIG_VT); const bf16* VT2 = (const bf16*)(ws + WS_BIG + BIG_VT2); const bf16* Yb = (const bf16*)(ws + WS_BIG + BIG_Y);
    const int i = threadIdx.x; const unsigned hsh = (unsigned)(i + 1) * 2654435761u;
    unsigned long long* slots = (unsigned long long*)(ws + 4096);
    if (which == 100) { if (i == 0) *flags = 0u; slots[i] = 0ull; return; }
    if (which == 101) { if (i == 0) { unsigned f = 0; for (int p = 0; p < 6; ++p) if (slots[2 * p] != slots[2 * p + 1]) f |= 1u << p; a.out[0] = 1000.f + 100.f * (float)f; } return; }
    if (which == 0) {
        const int row = hsh % NT, col = (hsh >> 7) % FF; float g = 0.f, u = 0.f;
        for (int k = 0; k < DM; ++k) { const float h = bfv(HN, (size_t)row * DM + k); g += h * a.in[2][(size_t)k * FF + col]; u += h * a.in[3][(size_t)k * FF + col]; }
        chk_flag(flags, 0, bfv(BIG, (size_t)row * FF + col), g / (1.f + expf(-g)) * u);
    } else if (which == 1) {
        const int row = hsh % NT, col = (i < 32) ? (hsh >> 7) % 3584 : 3584 + (hsh >> 7) % 1536; float p = 0.f;
        for (int k = 0; k < DM; ++k) p += bfv(HN, (size_t)row * DM + k) * a.in[5][(size_t)k * 5120 + col];
        chk_flag(flags, 1, col < 3584 ? bfv(BIG, (size_t)row * 3584 + col) : bfv(VT, (size_t)(col - 3584) * NT + row), p);
    } else if (which == 2) {
        const int tok = (i < 8) ? i * 4096 / 2 + i : hsh % NT, c = (hsh >> 9) % 512, g = c >> 7, d = c & 127, W = 2 << g, tpos = tok & 4095;
        const int nwin = tpos + 1 < W ? tpos + 1 : W; float y = 0.f;
        for (int cc = 0; cc < 128; ++cc) { float sm = 0.f; for (int q = 0; q < nwin; ++q) sm += bfv(BIG, (size_t)(tok - q) * 3584 + g * 128 + cc);
            y += (sm / nwin - bfv(BIG, (size_t)tok * 3584 + g * 128 + cc)) * a.in[6][((size_t)g * 128 + cc) * 128 + d]; }
        chk_flag(flags, 2, bfv(MIX, (size_t)tok * DM + c), y * a.in[7][c]);
    } else if (which == 3) {
        const int b = i & 3, h = (hsh >> 5) % 12, d = (hsh >> 11) & 127; const int t = (i < 16) ? i * 3 : (hsh >> 3) % 4096; const size_t tb = (size_t)b * 4096;
        float later = 0.f, acc = 0.f;
        for (int sidx = t - 1; sidx >= 0; --sidx) { float z = 0.f;
            for (int k = 0; k < 128; ++k) z += bfv(BIG, (tb + t) * 3584 + 512 + h * 128 + k) * bfv(BIG, (tb + sidx) * 3584 + 2048 + h * 128 + k);
            z *= 0.08838834764831845f;
            const float sp = log1pf(expf(-fabsf(z))); const float lsp = fminf(z, 0.f) - sp, lsn = -(fmaxf(z, 0.f) + sp);
            acc += expf(lsp + later) * bfv(VT, (size_t)(h * 128 + d) * NT + tb + sidx); later += lsn; if (later < -200.f) break; }
        chk_flag(flags, 3, bfv(MIX, (tb + t) * DM + 512 + h * 128 + d), acc);
        if (!(fabsf(bfv(MIX, (tb + t) * DM + 512 + h * 128 + d) - acc) <= 0.3f)) atomicOr(flags, 1u << 4);
    } else if (which == 4) {
        const int b = i & 3, g = (hsh >> 5) & 63, ch = (hsh >> 12) & 15; const int t = (i < 8) ? i * 9 : (i < 24 ? 60 + i * 7 : (hsh >> 3) % 1500); const size_t tb = (size_t)b * 4096;
        const float dt = expf(a.in[12][g]); float y = 0.f;
        for (int n = 0; n < 64; ++n) {
            const float are = a.in[10][g * 64 + n], aim = a.in[11][g * 64 + n]; const float mag = expf(are * dt); float sn, cs; sincos_f(aim * dt, sn, cs);
            const float lr = mag * cs, li = mag * sn, den = are * are + aim * aim, nr = lr - 1.f; const float fre = (nr * are + li * aim) / den, fim = (li * are - nr * aim) / den;
            float sr = 0.f, si = 0.f;
            for (int q = 0; q <= t; ++q) { float bur = 0.f, bui = 0.f;
                for (int c = 0; c < 16; ++c) { const float br = a.in[13][(size_t)(g * 64 + n) * 16 + c], bi = a.in[14][(size_t)(g * 64 + n) * 16 + c], u = bfv(BIG, (tb + q) * 2048 + g * 16 + c);
                    bur += (fre * br - fim * bi) * u; bui += (fre * bi + fim * br) * u; }
                const float nsr = lr * sr - li * si + bur; si = lr * si + li * sr + bui; sr = nsr; }
            y += a.in[15][(size_t)(g * 16 + ch) * 64 + n] * sr - a.in[16][(size_t)(g * 16 + ch) * 64 + n] * si; }
        y += a.in[17][g * 16 + ch] * bfv(BIG, (tb + t) * 2048 + g * 16 + ch);
        chk_flag(flags, 4, bfv(Yb, (tb + t) * 1024 + g * 16 + ch), pg8::gelu_f(y));
    } else if (which == 6) {
        const bf16* Fb = (const bf16*)(ws + WS_F); const int row = hsh % NT, col = (hsh >> 7) % DM; float f = 0.f;
        for (int k = 0; k < FF; ++k) f += bfv(BIG, (size_t)row * FF + k) * a.in[4][(size_t)k * DM + col];
        chk_flag(flags, 0, bfv(Fb, (size_t)row * DM + col), f);
    } else if (which == 7) {
        const bf16* Fb = (const bf16*)(ws + WS_F); const int row = 1 + hsh % (NT - 1), col = (hsh >> 7) % DM; float ss = 0.f, s2 = 0.f;
        for (int k = 0; k < DM; ++k) { const float f = bfv(Fb, (size_t)row * DM + k); ss += f * f; const float o = a.out[(size_t)row * DM + k]; s2 += o * o; }
        const float xn = a.in[0][(size_t)row * DM + col] + 0.5f * bfv(Fb, (size_t)row * DM + col) / sqrtf(ss / DM + EPS) * a.in[1][1 * DM + col];
        chk_flag(flags, 1, a.out[(size_t)row * DM + col], xn);
        chk_flag(flags, 1, bfv(HN, (size_t)row * DM + col), a.out[(size_t)row * DM + col] / sqrtf(s2 / DM + EPS) * a.in[1][2 * DM + col]);
    } else if (which == 8) {
        const bf16* Fb = (const bf16*)(ws + WS_F); const int row = hsh % NT, col = (hsh >> 7) % DM; float f = 0.f;
        for (int k = 0; k < DM; ++k) f += bfv(MIX, (size_t)row * DM + k) * a.in[8][(size_t)k * DM + col];
        chk_flag(flags, 2, bfv(Fb, (size_t)row * DM + col), f);
    } else if (which == 9) {
        const int row = hsh % NT, col = (hsh >> 7) % 1024; float f = a.in[19][col];
        for (int k = 0; k < 1024; ++k) f += bfv(Yb, (size_t)row * 1024 + k) * a.in[18][(size_t)k * 1024 + col];
        chk_flag(flags, 5, bfv(MIX, (size_t)row * DM + col), bfv(Yb, (size_t)row * 1024 + col) / (1.f + expf(-f)));
    } else if (which == 5) {
        const int tok = hsh % NT, h = (hsh >> 4) & 7, d = (hsh >> 9) & 127, t = tok & 127, tok0 = tok - t; float m = 0.f;
        for (int sidx = 0; sidx <= t; ++sidx) { float ss = 0.f; for (int c = 0; c < 1024; ++c) { const float v = bfv(VT2, (size_t)c * NT + tok0 + sidx); ss += v * v; }
            m += a.in[21][((size_t)h * 128 + t) * 128 + sidx] * bfv(VT2, (size_t)(h * 128 + d) * NT + tok0 + sidx) / sqrtf(ss / 1024.f + EPS); }
        const float o = bfv(BIG, (size_t)tok * 2048 + 1024 + h * 128 + d) * (a.in[20][h * 128 + d] * m + a.in[22][h * 128 + t]);
        chk_flag(flags, 5, bfv(MIX, (size_t)tok * DM + 1024 + h * 128 + d), o);
    }
}
#endif

#if MK_CHECK
__global__ void cks(const unsigned* buf, size_t nwords, unsigned long long* slot) {
    unsigned long long sum = 0; const size_t stride = (size_t)gridDim.x * blockDim.x;
    for (size_t i = (size_t)blockIdx.x * blockDim.x + threadIdx.x; i < nwords; i += stride) sum += (unsigned long long)buf[i] * (1 + (i & 1023));
    atomicAdd(slot, sum);
}
#endif
extern "C" void kernel_launch(void* const* d_in, const int* in_sizes, int n_in, void* d_out, int out_size, void* d_ws, size_t ws_size, hipStream_t stream) {
    static int grid = 0;
    if (grid == 0) {
        if (n_in != 24 || ws_size < WS_END) { fprintf(stderr, "kernel_launch: unexpected n_in %d or ws_size %zu (< %zu)\n", n_in, ws_size, (size_t)WS_END); grid = -1; return; }
        int dev = 0, cus = 0, per_cu = 0;
        (void)hipGetDevice(&dev); (void)hipDeviceGetAttribute(&cus, hipDeviceAttributeMultiprocessorCount, dev);
        if (hipFuncSetAttribute((const void*)fwd, hipFuncAttributeMaxDynamicSharedMemorySize, LDS_BYTES) != hipSuccess) { fprintf(stderr, "kernel_launch: hipFuncSetAttribute failed\n"); grid = -1; return; }
        if (hipOccupancyMaxActiveBlocksPerMultiprocessor(&per_cu, (const void*)fwd, 512, LDS_BYTES) != hipSuccess || per_cu < 1) per_cu = 1;
        (void)hipGetLastError();
        grid = cus * per_cu;
        if (grid <= 0) grid = 256;
    }
    if (grid < 0) return;
    Args a{};
    for (int i = 0; i < 24; ++i) a.in[i] = (const float*)d_in[i];
    a.out = (float*)d_out; a.ws = (unsigned char*)d_ws;
#if MK_MULTI
    for (int ph = 0; ph < MK_STOP; ++ph) {
        if (ph == 6 || ph == 7) continue;
        a.ph_lo = ph; a.ph_hi = ph + 1;
        hipLaunchKernelGGL(fwd, dim3(grid), dim3(512), LDS_BYTES, stream, a);
#if MK_CHECK
        {
            unsigned char* w8 = (unsigned char*)d_ws; unsigned long long* slots = (unsigned long long*)(w8 + 4096);
            if (ph == 0) hipLaunchKernelGGL(chk, dim3(1), dim3(64), 0, stream, a, 100);
            int pair = -1; const unsigned* buf = nullptr; size_t nw = 0;
            if (ph == 1) { pair = 0; buf = (const unsigned*)(w8 + WS_BIG); nw = (size_t)NT * FF / 2; }
            if (ph == 2) { pair = 1; buf = (const unsigned*)(w8 + WS_F); nw = (size_t)NT * DM / 2; }
            if (ph == 4) { pair = 2; buf = (const unsigned*)(w8 + WS_BIG); nw = (size_t)160 * MiB / 4; }
            if (ph == 5) { pair = 3; buf = (const unsigned*)(w8 + WS_MIX); nw = (size_t)NT * DM / 2; }
            if (ph == 8) { pair = 4; buf = (const unsigned*)(w8 + WS_F); nw = (size_t)NT * DM / 2; }
            if (ph == 3) { pair = 5; buf = (const unsigned*)(w8 + WS_HN); nw = (size_t)NT * DM / 2; }
            if (pair >= 0) {
                hipLaunchKernelGGL(cks, dim3(1024), dim3(256), 0, stream, buf, nw, slots + 2 * pair);
                if (ph != 3) hipLaunchKernelGGL(fwd, dim3(grid), dim3(512), LDS_BYTES, stream, a);
                hipLaunchKernelGGL(cks, dim3(1024), dim3(256), 0, stream, buf, nw, slots + 2 * pair + 1);
            }
            if (ph == N_PHASES - 1) hipLaunchKernelGGL(chk, dim3(1), dim3(64), 0, stream, a, 101);
        }
#endif
    }
#else
    a.ph_lo = 0; a.ph_hi = N_PHASES;
    (void)hipMemsetAsync(d_ws, 0, 65536, stream);
    void* args[] = {&a};
    hipError_t e = hipLaunchCooperativeKernel((const void*)fwd, dim3(grid), dim3(512), args, LDS_BYTES, stream);
    if (e != hipSuccess) fprintf(stderr, "kernel_launch: cooperative launch failed: %s (grid %d)\n", hipGetErrorString(e), grid);
#endif
}
```
